# Optimizing an MI355X kernel written in HIP

```python
import math
import jax, jax.numpy as jnp
from jax import lax
import numpy as np

D_MODEL = 2048
BATCH = 4
SEQ = 2048
DEPTH = 4

N_REC = (DEPTH + 1) // 2
N_ATT = DEPTH // 2

RG_WIDTH = 2048
RG_HEADS = 8
RG_BLOCK = RG_WIDTH // RG_HEADS
CONV_WIDTH = 4
RG_C = 8.0

HG_HEADS = 16
HG_DK = 128
HG_DV = 128
HG_QK = HG_HEADS * HG_DK
HG_WIDTH = HG_HEADS * HG_DV
HG_CHUNK = 64

REC_IN = 2 * RG_WIDTH + 2 * HG_QK + 2 * HG_WIDTH
REC_OUT = RG_WIDTH + HG_WIDTH
REC_SPLITS = (RG_WIDTH, 2 * RG_WIDTH, 2 * RG_WIDTH + HG_QK,
              2 * RG_WIDTH + 2 * HG_QK, 2 * RG_WIDTH + 2 * HG_QK + HG_WIDTH)

ATT_HEADS = 8
ATT_DH = 128
ATT_QK = ATT_HEADS * 2 * ATT_DH
ATT_WIDTH = ATT_HEADS * 2 * ATT_DH
ATT_IN = 2 * ATT_QK + 2 * ATT_WIDTH
ATT_SPLITS = (ATT_QK, 2 * ATT_QK, 2 * ATT_QK + ATT_WIDTH)
ATT_BLOCK = 128
ROPE_DIM = ATT_DH // 4
ROPE_THETA = 500000.0

NORM_EPS = 1e-6
SUBLN_EPS = 1e-5

kernel_name = 'hybrid_rglru_hgrn2_diffattn'


def rms_norm(x, g, eps=NORM_EPS):
    xf = x.astype(jnp.float32)
    y = xf * lax.rsqrt(jnp.mean(xf * xf, axis=-1, keepdims=True) + eps)
    return (y * g.astype(jnp.float32)).astype(x.dtype)


def causal_depthwise_conv(x, w, b):
    s = x.shape[1]
    xp = jnp.pad(x, ((0, 0), (CONV_WIDTH - 1, 0), (0, 0)))
    y = b
    for tap in range(CONV_WIDTH):
        y = y + xp[:, tap:tap + s] * w[tap]
    return y


def rg_lru(x, w_a, b_a, w_x, b_x, lam):
    bsz, s, _ = x.shape
    xb = x.reshape(bsz, s, RG_HEADS, RG_BLOCK)
    r = jax.nn.sigmoid(jnp.einsum('bshi,hij->bshj', xb, w_a).reshape(bsz, s, RG_WIDTH) + b_a)
    i = jax.nn.sigmoid(jnp.einsum('bshi,hij->bshj', xb, w_x).reshape(bsz, s, RG_WIDTH) + b_x)
    log_a = -RG_C * r.astype(jnp.float32) * jax.nn.softplus(-lam.astype(jnp.float32))
    a = jnp.exp(log_a)
    u = jnp.sqrt(-jnp.expm1(2.0 * log_a)) * (i * x).astype(jnp.float32)

    def combine(c1, c2):
        a1, u1 = c1
        a2, u2 = c2
        return a1 * a2, a2 * u1 + u2

    _, h = lax.associative_scan(combine, (a, u), axis=1)
    return h.astype(x.dtype)


def hgrn2_chunkwise(q, k, v, log_f):
    bsz, s, h, dk = q.shape
    dv = v.shape[-1]
    nc = s // HG_CHUNK

    def chunks(t):
        return t.reshape(bsz, nc, HG_CHUNK, h, t.shape[-1]).transpose(1, 0, 3, 2, 4)

    mask = jnp.tril(jnp.ones((HG_CHUNK, HG_CHUNK), dtype=bool))[:, :, None]

    def step(state, inp):
        qc, kc, vc, gc = inp
        b = jnp.cumsum(gc, axis=2)
        o_inter = jnp.einsum('bhtk,bhkv->bhtv', qc * jnp.exp(b), state)
        decay = jnp.exp(jnp.where(mask, b[:, :, :, None, :] - b[:, :, None, :, :], -jnp.inf))
        scores = jnp.einsum('bhtk,bhsk,bhtsk->bhts', qc, kc, decay)
        o = o_inter + jnp.einsum('bhts,bhsv->bhtv', scores, vc)
        b_last = b[:, :, -1:, :]
        state = (jnp.exp(b_last[:, :, 0, :, None]) * state
                 + jnp.einsum('bhsk,bhsv->bhkv', kc * jnp.exp(b_last - b), vc))
        return state, o

    s0 = jnp.zeros((bsz, h, dk, dv), jnp.float32)
    _, o = lax.scan(step, s0, (chunks(q), chunks(k), chunks(v), chunks(log_f)))
    return o.transpose(1, 0, 3, 2, 4).reshape(bsz, s, h, dv)


def partial_rope(x, pos):
    half = ROPE_DIM // 2
    inv_freq = ROPE_THETA ** (-jnp.arange(0, ROPE_DIM, 2, dtype=jnp.float32) / ROPE_DIM)
    ang = pos.astype(jnp.float32)[:, None] * inv_freq
    cos = jnp.cos(ang)[:, None, None, :]
    sin = jnp.sin(ang)[:, None, None, :]
    xr = x[..., :ROPE_DIM].astype(jnp.float32)
    x1, x2 = xr[..., :half], xr[..., half:]
    rot = jnp.concatenate([x1 * cos - x2 * sin, x2 * cos + x1 * sin], axis=-1)
    return jnp.concatenate([rot.astype(x.dtype), x[..., ROPE_DIM:]], axis=-1)


def diff_attention(q, k, v, lam):
    bsz, s, h, _, dh = q.shape
    nb = s // ATT_BLOCK
    scale = dh ** -0.5
    qb = q.reshape(bsz, nb, ATT_BLOCK, h, 2, dh).transpose(1, 0, 3, 4, 2, 5)
    kt = k.transpose(0, 2, 3, 1, 4)
    vt = v.transpose(0, 2, 1, 3)
    k_pos = jnp.arange(s)

    def one_block(args):
        q_blk, blk = args
        sc = jnp.einsum('bhiqd,bhikd->bhiqk', q_blk, kt).astype(jnp.float32) * scale
        q_pos = blk * ATT_BLOCK + jnp.arange(ATT_BLOCK)
        causal = k_pos[None, :] <= q_pos[:, None]
        p = jax.nn.softmax(jnp.where(causal, sc, -jnp.inf), axis=-1)
        attn = p[:, :, 0] - lam * p[:, :, 1]
        return jnp.einsum('bhqk,bhkv->bhqv', attn.astype(v.dtype), vt)

    o = lax.map(one_block, (qb, jnp.arange(nb)))
    return o.transpose(1, 0, 3, 2, 4).reshape(bsz, s, h, 2 * dh)


def setup_inputs(seed: int = 0) -> dict:
    key = jax.random.key(seed)
    ks = jax.random.split(key, 24)
    f32 = jnp.float32

    def nrm(k, shape, scale):
        return jax.random.normal(k, shape, f32) * scale

    u = jax.random.uniform(ks[10], (N_REC, RG_WIDTH), f32, 0.9, 0.999)
    a0 = u ** (1.0 / RG_C)
    rg_lambda = jnp.log(a0) - jnp.log1p(-a0)
    return {
        'x': nrm(ks[0], (BATCH, SEQ, D_MODEL), 1.0),
        'rec_norm': 1.0 + nrm(ks[1], (N_REC, D_MODEL), 0.01),
        'rec_w_in': nrm(ks[2], (N_REC, D_MODEL, REC_IN), D_MODEL ** -0.5),
        'rg_conv_w': nrm(ks[3], (N_REC, CONV_WIDTH, RG_WIDTH), CONV_WIDTH ** -0.5),
        'rg_conv_b': nrm(ks[4], (N_REC, RG_WIDTH), 0.01),
        'rg_w_gate_a': nrm(ks[5], (N_REC, RG_HEADS, RG_BLOCK, RG_BLOCK), RG_BLOCK ** -0.5),
        'rg_b_gate_a': nrm(ks[6], (N_REC, RG_WIDTH), 0.01),
        'rg_w_gate_x': nrm(ks[7], (N_REC, RG_HEADS, RG_BLOCK, RG_BLOCK), RG_BLOCK ** -0.5),
        'rg_b_gate_x': nrm(ks[8], (N_REC, RG_WIDTH), 0.01),
        'rg_lambda': rg_lambda,
        'hg_lb': nrm(ks[11], (N_REC, HG_QK), 0.5),
        'hg_out_norm': 1.0 + nrm(ks[12], (N_REC, HG_DV), 0.01),
        'rec_w_out': nrm(ks[13], (N_REC, REC_OUT, D_MODEL), REC_OUT ** -0.5),
        'att_norm': 1.0 + nrm(ks[14], (N_ATT, D_MODEL), 0.01),
        'att_w_in': nrm(ks[15], (N_ATT, D_MODEL, ATT_IN), D_MODEL ** -0.5),
        'att_q_norm': 1.0 + nrm(ks[16], (N_ATT, ATT_DH), 0.01),
        'att_k_norm': 1.0 + nrm(ks[17], (N_ATT, ATT_DH), 0.01),
        'att_lambda': nrm(ks[18], (N_ATT, 4, ATT_DH), 0.1),
        'att_sub_norm': 1.0 + nrm(ks[19], (N_ATT, 2 * ATT_DH), 0.01),
        'att_w_out': nrm(ks[20], (N_ATT, ATT_WIDTH, D_MODEL), ATT_WIDTH ** -0.5),
    }


def reference(x, rec_norm, rec_w_in, rg_conv_w, rg_conv_b, rg_w_gate_a, rg_b_gate_a,
              rg_w_gate_x, rg_b_gate_x, rg_lambda, hg_lb, hg_out_norm, rec_w_out,
              att_norm, att_w_in, att_q_norm, att_k_norm, att_lambda, att_sub_norm,
              att_w_out):
    bsz, s, _ = x.shape
    pos = jnp.arange(s)
    lb_all = jnp.cumsum(jax.nn.softmax(hg_lb.astype(jnp.float32), axis=0), axis=0)
    lb_all = lb_all - lb_all[0]

    for layer in range(DEPTH):
        j = layer // 2
        if layer % 2 == 0:
            h = rms_norm(x, rec_norm[j])
            proj = h @ rec_w_in[j]
            rg_x, rg_g, hg_q, hg_f, hg_i, hg_g = jnp.split(proj, REC_SPLITS, axis=-1)
            rg_x = causal_depthwise_conv(rg_x, rg_conv_w[j], rg_conv_b[j])
            rg_h = rg_lru(rg_x, rg_w_gate_a[j], rg_b_gate_a[j], rg_w_gate_x[j],
                          rg_b_gate_x[j], rg_lambda[j])
            y_a = rg_h * jax.nn.silu(rg_g)
            lb = lb_all[j]
            q = (jax.nn.silu(hg_q).astype(jnp.float32) * HG_DK ** -0.5).reshape(bsz, s, HG_HEADS, HG_DK)
            log_f = jnp.logaddexp(jnp.log(lb), jnp.log1p(-lb) + jax.nn.log_sigmoid(hg_f.astype(jnp.float32)))
            k = -jnp.expm1(log_f)
            o = hgrn2_chunkwise(q,
                                k.reshape(bsz, s, HG_HEADS, HG_DK),
                                hg_i.astype(jnp.float32).reshape(bsz, s, HG_HEADS, HG_DV),
                                log_f.reshape(bsz, s, HG_HEADS, HG_DK))
            o = rms_norm(o.astype(x.dtype), hg_out_norm[j])
            y_b = o.reshape(bsz, s, HG_WIDTH) * jax.nn.silu(hg_g)
            y = jnp.concatenate([y_a, y_b], axis=-1) @ rec_w_out[j]
        else:
            h = rms_norm(x, att_norm[j])
            proj = h @ att_w_in[j]
            q, k, v, g = jnp.split(proj, ATT_SPLITS, axis=-1)
            q = partial_rope(rms_norm(q.reshape(bsz, s, ATT_HEADS, 2, ATT_DH), att_q_norm[j]), pos)
            k = partial_rope(rms_norm(k.reshape(bsz, s, ATT_HEADS, 2, ATT_DH), att_k_norm[j]), pos)
            v = v.reshape(bsz, s, ATT_HEADS, 2 * ATT_DH)
            lam_init = 0.8 - 0.6 * math.exp(-0.3 * layer)
            lp = att_lambda[j].astype(jnp.float32)
            lam = jnp.exp(jnp.sum(lp[0] * lp[1])) - jnp.exp(jnp.sum(lp[2] * lp[3])) + lam_init
            o = diff_attention(q, k, v, lam)
            o = rms_norm(o, att_sub_norm[j], SUBLN_EPS) * (1.0 - lam_init)
            y = (o.reshape(bsz, s, ATT_WIDTH) * jax.nn.silu(g)) @ att_w_out[j]
        x = x + y.astype(x.dtype)
    return x
```

```cpp
#include <hip/hip_runtime.h>
#include <hip/hip_cooperative_groups.h>
#include <cstdio>
#include <cstdint>
#include <cmath>
#include <cstring>
namespace cg = cooperative_groups;

#define LAS __attribute__((address_space(3)))
typedef unsigned short bf16_t;
typedef short bf16x8 __attribute__((ext_vector_type(8)));
typedef float f32x4 __attribute__((ext_vector_type(4)));
typedef float f32x2 __attribute__((ext_vector_type(2)));
typedef unsigned u32x4 __attribute__((ext_vector_type(4)));
typedef unsigned u32x2 __attribute__((ext_vector_type(2)));

constexpr int T_ = 8192, S_ = 2048, NB_ = 4;
constexpr int REC_IN = 12288, REC_OUT = 4096, ATT_IN = 8192;
constexpr int NTHR = 512;
constexpr int LDS_BYTES = 147456;

constexpr size_t SZ_W_REC_IN = (size_t)2 * REC_IN * 2048 * 2, SZ_W_REC_OUT = (size_t)2 * 2048 * REC_OUT * 2, SZ_W_ATT_IN = (size_t)2 * ATT_IN * 2048 * 2,
                 SZ_W_ATT_OUT = (size_t)2 * 2048 * 2048 * 2, SZ_W_GATE = (size_t)2 * 16 * 256 * 256 * 2;
constexpr size_t WS_W_REC_IN = 0, WS_W_REC_OUT = WS_W_REC_IN + SZ_W_REC_IN, WS_W_ATT_IN = WS_W_REC_OUT + SZ_W_REC_OUT, WS_W_ATT_OUT = WS_W_ATT_IN + SZ_W_ATT_IN,
                 WS_W_GATE = WS_W_ATT_OUT + SZ_W_ATT_OUT;
constexpr size_t WS_X = WS_W_GATE + SZ_W_GATE;
constexpr size_t WS_H = WS_X + (size_t)T_ * 2048 * 4;
constexpr size_t WS_PROJ = WS_H + (size_t)T_ * 2048 * 2;
constexpr size_t WS_S0 = WS_PROJ + (size_t)T_ * REC_IN * 2;
constexpr size_t WS_S1 = WS_S0 + (size_t)T_ * 2048 * 4;
constexpr size_t WS_ORAW = WS_S1 + (size_t)T_ * 2048 * 4;
constexpr size_t WS_Y = WS_ORAW + (size_t)T_ * 2048 * 2;
constexpr size_t WS_SUM = WS_Y + (size_t)T_ * REC_OUT * 2;
constexpr size_t WS_SMALL = WS_SUM + (size_t)2 * 4 * 32 * 2048 * 4;
constexpr size_t WS_SS = WS_SMALL + 65536;
constexpr size_t WS_ROPE = WS_SS + (size_t)3 * T_ * 4;
constexpr size_t WS_END = WS_ROPE + (size_t)S_ * 32 * 4;

struct Params {
    const float* in[20];
    float* out;
    unsigned char* ws;
    float inv_freq[16];
    float lam_init[2];
    int ph_lo, ph_hi;
};

__device__ __forceinline__ float bf2f(unsigned v) { return __uint_as_float(v << 16); }
__device__ __forceinline__ unsigned cvt_pk_bf16(float lo, float hi) { unsigned r; asm volatile("v_cvt_pk_bf16_f32 %0, %1, %2" : "=v"(r) : "v"(lo), "v"(hi)); return r; }
typedef __bf16 bf16pair_t __attribute__((ext_vector_type(2)));
__device__ __forceinline__ unsigned cvt_pk_bf16_v(float lo, float hi) { const f32x2 v = {lo, hi}; return __builtin_bit_cast(unsigned, __builtin_convertvector(v, bf16pair_t)); }
__device__ __forceinline__ float bflo(unsigned w) { return __uint_as_float(w << 16); }
__device__ __forceinline__ float bfhi(unsigned w) { return __uint_as_float(w & 0xffff0000u); }
__device__ __forceinline__ float sigmoidf_(float x) { return __builtin_amdgcn_rcpf(1.f + __expf(-x)); }
__device__ __forceinline__ float siluf_(float x) { return x * __builtin_amdgcn_rcpf(1.f + __expf(-x)); }
__device__ __forceinline__ float wave_sum(float v) {
#pragma unroll
    for (int o = 32; o > 0; o >>= 1) v += __shfl_xor(v, o);
    return v;
}
__device__ __forceinline__ float wave_max(float v) {
#pragma unroll
    for (int o = 32; o > 0; o >>= 1) v = fmaxf(v, __shfl_xor(v, o));
    return v;
}

__device__ __forceinline__ float neg_expm1(float y) {
    const float ser = -y * (1.f + y * (0.5f + y * (0.16666667f + y * (0.041666668f + y * 0.0083333338f))));
    return y > -0.25f ? ser : 1.f - __expf(y);
}
__device__ __forceinline__ int lane_fresh() { int l; asm volatile("v_mbcnt_lo_u32_b32 %0, -1, 0\n\tv_mbcnt_hi_u32_b32 %0, -1, %0" : "=v"(l)); return l; }
#define tid_opaque() (wid_s * 64 + lane_fresh())

namespace pg8 {
constexpr int BM = 256, BK = 64, HALF = 128, HTB = HALF * BK * 2, STAGE_BYTES = 8 * HTB, NXCD = 8, WGM = 8;
__host__ __device__ __forceinline__ int lds_byte(int r, int c) { const int st = (r >> 4) * 2 + (c >> 5), rr = r & 15, cc = c & 31, ob = rr * 64 + cc * 2; return st * 1024 + (ob ^ (((ob >> 9) & 1) << 5)); }
__host__ __device__ __forceinline__ void stage_rc(int b, int& R, int& C) { const int st = b / 1024, sb = b % 1024, swz = sb ^ (((sb >> 9) & 1) << 5); R = (st >> 1) * 16 + swz / 64; C = (st & 1) * 32 + (swz % 64) / 2; }
__host__ __device__ __forceinline__ int perm32(int rho) { const int n = rho >> 4, i = rho & 15; return 8 * (i >> 2) + 4 * n + (i & 3); }

struct Unit { int pm, pn, kofs; };
struct Gemm { const bf16_t* A; const bf16_t* Bt; int lda, K; };

struct StaticOrder {
    int nM, nN, nwg, G, c;
    __device__ void init(int M, int N, int G_, int c_) { nM = M / BM; nN = N / BM; nwg = nM * nN; G = G_; c = c_; }
    __device__ bool next(int i, Unit& u) const {
        const long L = (long)i * G + c; if (L >= nwg) return false;
        int wgid = (int)L; { const int q = nwg / NXCD, r = nwg % NXCD, xcd = wgid % NXCD, off = wgid / NXCD; wgid = (xcd < r ? xcd * (q + 1) : r * (q + 1) + (xcd - r) * q) + off; }
        const int nig = WGM * nN, gid = wgid / nig, fm = gid * WGM, gsz = (nM - fm) < WGM ? (nM - fm) : WGM;
        u.pm = fm + ((wgid % nig) % gsz); u.pn = (wgid % nig) / gsz; u.kofs = 0; return true;
    }
};
struct GateOrder {
    int G, c;
    __device__ bool next(int i, Unit& u) const {
        const int L = i * G + c; if (L >= 512) return false;
        u.pm = L & 31; u.pn = L >> 5; u.kofs = (u.pn >> 1) * 256; return true;
    }
};

template <class Epi, class Sched>
__device__ __forceinline__ void gemm_phase(const int wid_s, LAS unsigned char* lds, const Gemm g, const Sched& S, const Epi& E) {
    const int lane = lane_fresh(), wid = wid_s, tid = wid * 64 + lane; const int wr = wid >> 2, wc = wid & 3, fr = lane & 15, fq = lane >> 4;
    const int K = g.K, lda = g.lda, nt = K / BK;
    unsigned voffA[2], voffB[2];
#pragma unroll
    for (int i = 0; i < 2; ++i) { int R, C; stage_rc(tid * 16 + i * 8192, R, C); const int Rb = (R & ~31) + perm32(R & 31);
        voffA[i] = (unsigned)(R * lda + C) * 2u; voffB[i] = (unsigned)(Rb * K + C) * 2u; }
    const size_t kstep = (size_t)(BK * 2);
    const size_t hstepA = (size_t)HALF * lda * 2, hstepB = (size_t)HALF * K * 2;
    const size_t tstepA = 2 * hstepA, tstepB = 2 * hstepB;
    const unsigned ldsw = (unsigned)wid * 1024u;
    const int aoff = lds_byte(wr * 64 + fr, fq * 8), boff = lds_byte(wc * 32 + fr, fq * 8);
#define PG8_SA(b, h) (((b) * 2 + (h)) * HTB)
#define PG8_SB(b, h) ((4 + (b) * 2 + (h)) * HTB)
#define PG8_STAGE(bufoff, gbase, voff) do { _Pragma("unroll") for (int _i = 0; _i < 2; ++_i) \
        __builtin_amdgcn_global_load_lds((const unsigned*)((const char*)(gbase) + (voff)[_i]), (LAS unsigned*)(lds + (bufoff) + ldsw + _i * 8192), 16, 0, 0); } while (0)
#define PG8_LDA(dst, b, h) do { _Pragma("unroll") for (int m = 0; m < 4; ++m) _Pragma("unroll") for (int k = 0; k < 2; ++k) dst[m][k] = *(const LAS bf16x8*)(lds + PG8_SA(b, h) + aoff + m * 2048 + k * 1024); } while (0)
#define PG8_LDB(dst, b, h) do { _Pragma("unroll") for (int n = 0; n < 2; ++n) _Pragma("unroll") for (int k = 0; k < 2; ++k) dst[n][k] = *(const LAS bf16x8*)(lds + PG8_SB(b, h) + boff + n * 2048 + k * 1024); } while (0)
#define PG8_MMA(ai, bj, At, Bt) do { __builtin_amdgcn_s_setprio(1); _Pragma("unroll") for (int m = 0; m < 4; ++m) _Pragma("unroll") for (int n = 0; n < 2; ++n) _Pragma("unroll") for (int k = 0; k < 2; ++k) \
        acc[ai][bj][m][n] = __builtin_amdgcn_mfma_f32_16x16x32_bf16(Bt[n][k], At[m][k], acc[ai][bj][m][n], 0, 0, 0); __builtin_amdgcn_s_setprio(0); } while (0)
#define PG8_WAIT_V(n) asm volatile("s_waitcnt vmcnt(" #n ")" ::: "memory")
#define PG8_WAIT_L(n) asm volatile("s_waitcnt lgkmcnt(" #n ")" ::: "memory")
#define PG8_BAR __builtin_amdgcn_s_barrier()
#define PG8_SCHED __builtin_amdgcn_sched_barrier(0)
    Unit cur, nxt; int ui = 0;
    if (!S.next(0, cur)) return;
    f32x4 acc[2][2][4][2];
#pragma unroll
    for (int a = 0; a < 2; ++a)
#pragma unroll
        for (int b = 0; b < 2; ++b)
#pragma unroll
            for (int m = 0; m < 4; ++m)
#pragma unroll
                for (int n = 0; n < 2; ++n) acc[a][b][m][n] = (f32x4){0.f, 0.f, 0.f, 0.f};
    bf16x8 At[4][2], B0[2][2], B1[2][2];
    const char* cA = (const char*)g.A + (size_t)cur.pm * tstepA + (size_t)cur.kofs * 2; const char* cB = (const char*)g.Bt + (size_t)cur.pn * tstepB;
    {
        PG8_STAGE(PG8_SB(0, 0), cB, voffB); PG8_STAGE(PG8_SB(0, 1), cB + hstepB, voffB); PG8_STAGE(PG8_SA(0, 0), cA, voffA); PG8_STAGE(PG8_SA(0, 1), cA + hstepA, voffA);
        if (wr == 1) PG8_BAR;
        PG8_WAIT_V(2); PG8_BAR;
        PG8_STAGE(PG8_SB(1, 0), cB + kstep, voffB); PG8_STAGE(PG8_SA(1, 0), cA + kstep, voffA); PG8_STAGE(PG8_SB(1, 1), cB + hstepB + kstep, voffB);
        PG8_WAIT_V(6); PG8_BAR;
    }
    for (;;) {
        const bool has_next = S.next(ui + 1, nxt);
        const char* nA = has_next ? (const char*)g.A + (size_t)nxt.pm * tstepA + (size_t)nxt.kofs * 2 : cA; const char* nB = has_next ? (const char*)g.Bt + (size_t)nxt.pn * tstepB : cB;
        for (int t = 0; t < nt; t += 2) {
            const bool last = (t == nt - 2);
            const char* a1 = cA + (size_t)(t + 1) * kstep;
            const char* a2 = last ? nA : cA + (size_t)(t + 2) * kstep; const char* b2 = last ? nB : cB + (size_t)(t + 2) * kstep;
            const char* a3 = a2 + kstep; const char* b3 = b2 + kstep;
            PG8_LDB(B0, 0, 0); PG8_LDB(B1, 0, 1); PG8_SCHED; PG8_LDA(At, 0, 0); PG8_STAGE(PG8_SA(1, 1), a1 + hstepA, voffA);
            PG8_WAIT_V(8); PG8_WAIT_L(0); PG8_BAR; PG8_MMA(0, 0, At, B0); PG8_MMA(0, 1, At, B1); PG8_BAR; PG8_SCHED;
            PG8_LDA(At, 0, 1); PG8_STAGE(PG8_SB(0, 0), b2, voffB); PG8_STAGE(PG8_SB(0, 1), b2 + hstepB, voffB); PG8_STAGE(PG8_SA(0, 0), a2, voffA);
            PG8_WAIT_V(8); PG8_WAIT_L(0); PG8_BAR; PG8_MMA(1, 0, At, B0); PG8_MMA(1, 1, At, B1); PG8_BAR; PG8_SCHED;
            PG8_LDB(B0, 1, 0); PG8_LDB(B1, 1, 1); PG8_SCHED; PG8_LDA(At, 1, 0); PG8_STAGE(PG8_SA(0, 1), a2 + hstepA, voffA);
            PG8_WAIT_V(8); PG8_WAIT_L(0); PG8_BAR; PG8_MMA(0, 0, At, B0); PG8_MMA(0, 1, At, B1); PG8_BAR; PG8_SCHED;
            PG8_LDA(At, 1, 1); PG8_STAGE(PG8_SB(1, 0), b3, voffB); PG8_STAGE(PG8_SB(1, 1), b3 + hstepB, voffB); PG8_STAGE(PG8_SA(1, 0), a3, voffA);
            PG8_WAIT_V(8); PG8_WAIT_L(0); PG8_BAR; PG8_MMA(1, 0, At, B0); PG8_MMA(1, 1, At, B1); PG8_BAR; PG8_SCHED;
        }
        if (wr == 0) PG8_BAR;
        { const int l2 = lane_fresh(); E(acc, cur, wr, wc, l2 & 15, l2 >> 4); }
        if (!has_next) break;
#pragma unroll
        for (int a = 0; a < 2; ++a)
#pragma unroll
            for (int b = 0; b < 2; ++b)
#pragma unroll
                for (int m = 0; m < 4; ++m)
#pragma unroll
                    for (int n = 0; n < 2; ++n) acc[a][b][m][n] = (f32x4){0.f, 0.f, 0.f, 0.f};
        cur = nxt; cA = nA; cB = nB; ++ui;
        if (wr == 1) PG8_BAR;
    }
    PG8_WAIT_V(0);
    PG8_BAR;
#undef PG8_SA
#undef PG8_SB
#undef PG8_STAGE
#undef PG8_LDA
#undef PG8_LDB
#undef PG8_MMA
#undef PG8_WAIT_V
#undef PG8_WAIT_L
#undef PG8_BAR
#undef PG8_SCHED
}

__device__ __forceinline__ void store8_bf16(bf16_t* p, f32x4 v0, f32x4 v1) {
    u32x4 w; w.x = cvt_pk_bf16(v0[0], v0[1]); w.y = cvt_pk_bf16(v0[2], v0[3]); w.z = cvt_pk_bf16(v1[0], v1[1]); w.w = cvt_pk_bf16(v1[2], v1[3]);
    *(u32x4*)p = w;
}
__device__ __forceinline__ f32x4 silu4(f32x4 v, float s) { f32x4 r; r[0] = siluf_(v[0]) * s; r[1] = siluf_(v[1]) * s; r[2] = siluf_(v[2]) * s; r[3] = siluf_(v[3]) * s; return r; }
__device__ __forceinline__ float logf_gate(float v, float lb) {
    const float ls = fminf(v, 0.f) - __logf(1.f + __expf(-fabsf(v)));
    return lb > 0.f ? __logf(lb + (1.f - lb) * __expf(ls)) : ls;
}

struct EpiRecIn {
    bf16_t* proj; float* logfb; const float* lb; const float* ssq;
    __device__ __forceinline__ void operator()(const f32x4 (&acc)[2][2][4][2], const Unit& u, int wr, int wc, int fr, int fq) const {
        const int row0 = u.pm * BM + wr * 64 + fr, colt = u.pn * BM, seg = colt >> 11, col0 = colt + wc * 32 + 8 * fq;
#pragma unroll
        for (int ai = 0; ai < 2; ++ai)
#pragma unroll
            for (int m = 0; m < 4; ++m) {
                const size_t row = (size_t)(row0 + ai * HALF + m * 16);
                const float rs = ssq ? rsqrtf(ssq[row] * (1.f / 2048.f) + 1e-6f) : 1.f;
#pragma unroll
                for (int bj = 0; bj < 2; ++bj) {
                    const int c = col0 + bj * HALF;
                    f32x4 v0 = acc[ai][bj][m][0] * rs, v1 = acc[ai][bj][m][1] * rs;
                    if (seg == 3) {
                        const int cc = c - 6144;
                        const f32x4 l0 = *(const f32x4*)(lb + cc), l1 = *(const f32x4*)(lb + cc + 4);
                        f32x4 o0, o1;
                        f32x4 k0, k1;
#pragma unroll
                        for (int e = 0; e < 4; ++e) { o0[e] = logf_gate(v0[e], l0[e]) * 1.4426950408889634f; o1[e] = logf_gate(v1[e], l1[e]) * 1.4426950408889634f;     k0[e] = (1.f - l0[e]) * sigmoidf_(-v0[e]); k1[e] = (1.f - l1[e]) * sigmoidf_(-v1[e]); }
                        *(f32x4*)(logfb + row * 2048 + cc) = o0; *(f32x4*)(logfb + row * 2048 + cc + 4) = o1;
                        store8_bf16(proj + row * REC_IN + c, k0, k1);
                    } else {
                        if (seg == 1 || seg == 5) { v0 = silu4(v0, 1.f); v1 = silu4(v1, 1.f); }
                        else if (seg == 2) { v0 = silu4(v0, 0.08838834764831845f); v1 = silu4(v1, 0.08838834764831845f); }
                        store8_bf16(proj + row * REC_IN + c, v0, v1);
                    }
                }
            }
    }
};
struct EpiAttIn {
    bf16_t* proj; const float* ssq; const float* qn; const float* kn; const float* ropetab; bf16_t* vT; LAS unsigned char* xlds;
    __device__ __forceinline__ void operator()(const f32x4 (&acc)[2][2][4][2], const Unit& u, int wr, int wc, int fr, int fq) const {
        const int row0 = u.pm * BM + wr * 64 + fr, colt = u.pn * BM, seg = colt >> 11, col0 = colt + wc * 32 + 8 * fq;
        if (seg < 2) {
            LAS float* xs = (LAS float*)xlds;
            float rsv[2][4];
#pragma unroll
            for (int ai = 0; ai < 2; ++ai)
#pragma unroll
                for (int m = 0; m < 4; ++m) {
                    const int rl = wr * 64 + ai * HALF + m * 16 + fr;
                    const float rs = rsqrtf(ssq[(size_t)(u.pm * BM + rl)] * (1.f / 2048.f) + 1e-6f);
                    rsv[ai][m] = rs;
#pragma unroll
                    for (int bj = 0; bj < 2; ++bj) {
                        const f32x4 a0 = acc[ai][bj][m][0] * rs, a1 = acc[ai][bj][m][1] * rs;
                        float ps = a0[0] * a0[0] + a0[1] * a0[1] + a0[2] * a0[2] + a0[3] * a0[3] + a1[0] * a1[0] + a1[1] * a1[1] + a1[2] * a1[2] + a1[3] * a1[3];
                        ps += __shfl_xor(ps, 16); ps += __shfl_xor(ps, 32);
                        if (fq == 0) xs[(rl * 2 + bj) * 4 + wc] = ps;
                    }
                }
            asm volatile("s_waitcnt lgkmcnt(0)" ::: "memory");
            __builtin_amdgcn_s_barrier();
            asm volatile("" ::: "memory");
            const float* gw = (seg == 0 ? qn : kn) + wc * 32 + 8 * fq;
            const f32x4 g0 = *(const f32x4*)gw, g1 = *(const f32x4*)(gw + 4);
            const float qs = seg == 0 ? 0.12751743f : 1.f;
#pragma unroll
            for (int ai = 0; ai < 2; ++ai)
#pragma unroll
                for (int m = 0; m < 4; ++m) {
                    const int rl = wr * 64 + ai * HALF + m * 16 + fr;
                    const size_t row = (size_t)(u.pm * BM + rl);
                    f32x4 c0 = (f32x4){1.f, 1.f, 1.f, 1.f}, c1 = c0, s0 = (f32x4){0.f, 0.f, 0.f, 0.f}, s1 = s0;
                    if (wc == 0) {
                        const float* rp = ropetab + (size_t)(row & (S_ - 1)) * 32 + (fq & 1) * 8;
                        c0 = *(const f32x4*)rp; c1 = *(const f32x4*)(rp + 4); s0 = *(const f32x4*)(rp + 16); s1 = *(const f32x4*)(rp + 20);
                        if (fq < 2) { s0 = -s0; s1 = -s1; }
                    }
#pragma unroll
                    for (int bj = 0; bj < 2; ++bj) {
                        const f32x4 pv = *(const LAS f32x4*)(xs + (rl * 2 + bj) * 4);
                        const float rstd = rsqrtf((pv[0] + pv[1] + pv[2] + pv[3]) * (1.f / 128.f) + 1e-6f) * qs;
                        f32x4 v0 = acc[ai][bj][m][0] * rsv[ai][m] * g0, v1 = acc[ai][bj][m][1] * rsv[ai][m] * g1;
                        if (wc == 0) {
                            f32x4 o0, o1;
#pragma unroll
                            for (int e = 0; e < 4; ++e) { o0[e] = __shfl_xor(v0[e], 32); o1[e] = __shfl_xor(v1[e], 32); }
                            v0 = v0 * c0 + o0 * s0; v1 = v1 * c1 + o1 * s1;
                        }
                        store8_bf16(proj + row * ATT_IN + col0 + bj * HALF, v0 * rstd, v1 * rstd);
                    }
                }
        } else if (seg == 2) {
#pragma unroll
            for (int ai = 0; ai < 2; ++ai)
#pragma unroll
                for (int m = 0; m < 4; ++m) {
                    const int row = row0 + ai * HALF + m * 16;
                    const float rs = rsqrtf(ssq[row] * (1.f / 2048.f) + 1e-6f);
                    const int bb = row >> 11, sp = row & (S_ - 1);
#pragma unroll
                    for (int bj = 0; bj < 2; ++bj) {
                        const int c = col0 + bj * HALF - 4096;
                        bf16_t* dst = vT + ((size_t)(bb * 8) * 256 + c) * S_ + sp;
                        const f32x4 a0 = acc[ai][bj][m][0] * rs, a1 = acc[ai][bj][m][1] * rs;
                        const unsigned w0 = cvt_pk_bf16(a0[0], a0[1]), w1 = cvt_pk_bf16(a0[2], a0[3]), w2 = cvt_pk_bf16(a1[0], a1[1]), w3 = cvt_pk_bf16(a1[2], a1[3]);
                        dst[0] = (bf16_t)(w0 & 0xffffu); dst[S_] = (bf16_t)(w0 >> 16); dst[2 * S_] = (bf16_t)(w1 & 0xffffu); dst[3 * S_] = (bf16_t)(w1 >> 16);
                        dst[4 * S_] = (bf16_t)(w2 & 0xffffu); dst[5 * S_] = (bf16_t)(w2 >> 16); dst[6 * S_] = (bf16_t)(w3 & 0xffffu); dst[7 * S_] = (bf16_t)(w3 >> 16);
                    }
                }
        } else {
#pragma unroll
            for (int ai = 0; ai < 2; ++ai)
#pragma unroll
                for (int m = 0; m < 4; ++m) {
                    const size_t row = (size_t)(row0 + ai * HALF + m * 16);
                    const float rs = rsqrtf(ssq[row] * (1.f / 2048.f) + 1e-6f);
#pragma unroll
                    for (int bj = 0; bj < 2; ++bj)
                        store8_bf16(proj + row * ATT_IN + col0 + bj * HALF, silu4(acc[ai][bj][m][0] * rs, 1.f), silu4(acc[ai][bj][m][1] * rs, 1.f));
                }
        }
    }
};
struct EpiResid {
    const float* xin; float* xout; const float* gnext; bf16_t* hnext; float* ssq;
    __device__ __forceinline__ void operator()(const f32x4 (&acc)[2][2][4][2], const Unit& u, int wr, int wc, int fr, int fq) const {
        const int row0 = u.pm * BM + wr * 64 + fr, col0 = u.pn * BM + wc * 32 + 8 * fq;
        const bool nx = gnext != nullptr;
#pragma unroll
        for (int ai = 0; ai < 2; ++ai)
#pragma unroll
            for (int m = 0; m < 4; ++m) {
                const size_t row = (size_t)(row0 + ai * HALF + m * 16);
                float ps = 0.f;
#pragma unroll
                for (int bj = 0; bj < 2; ++bj) {
                    const size_t idx = row * 2048 + col0 + bj * HALF;
                    const f32x4 x0 = *(const f32x4*)(xin + idx) + acc[ai][bj][m][0], x1 = *(const f32x4*)(xin + idx + 4) + acc[ai][bj][m][1];
                    *(f32x4*)(xout + idx) = x0; *(f32x4*)(xout + idx + 4) = x1;
                    if (nx) {
                        const f32x4 g0 = *(const f32x4*)(gnext + col0 + bj * HALF), g1 = *(const f32x4*)(gnext + col0 + bj * HALF + 4);
                        store8_bf16(hnext + idx, x0 * g0, x1 * g1);
                        ps += x0[0] * x0[0] + x0[1] * x0[1] + x0[2] * x0[2] + x0[3] * x0[3] + x1[0] * x1[0] + x1[1] * x1[1] + x1[2] * x1[2] + x1[3] * x1[3];
                    }
                }
                if (nx) {
                    ps += __shfl_xor(ps, 16); ps += __shfl_xor(ps, 32);
                    if (fq == 0) (void)__hip_atomic_fetch_add(ssq + row, ps, __ATOMIC_RELAXED, __HIP_MEMORY_SCOPE_AGENT);
                }
            }
    }
};
struct EpiGate {
    const bf16_t* xc; const float* ba; const float* bx; const float* lam; bf16_t* a_out; bf16_t* u_out;
    __device__ __forceinline__ void operator()(const f32x4 (&acc)[2][2][4][2], const Unit& u, int wr, int wc, int fr, int fq) const {
        const int row0 = u.pm * BM + wr * 64 + fr;
        const int c0 = (u.pn >> 1) * 256 + (u.pn & 1) * 128 + wc * 32 + 8 * fq;
        float bav[8], bxv[8], spv[8];
#pragma unroll
        for (int e = 0; e < 8; ++e) { bav[e] = ba[c0 + e]; bxv[e] = bx[c0 + e]; const float l = lam[c0 + e]; spv[e] = -8.f * (fmaxf(-l, 0.f) + __logf(1.f + __expf(-fabsf(l)))); }
#pragma unroll
        for (int ai = 0; ai < 2; ++ai)
#pragma unroll
            for (int m = 0; m < 4; ++m) {
                const size_t idx = (size_t)(row0 + ai * HALF + m * 16) * 2048 + c0;
                const u32x4 xw = *(const u32x4*)(xc + idx);
                float xv[8] = {bflo(xw.x), bfhi(xw.x), bflo(xw.y), bfhi(xw.y), bflo(xw.z), bfhi(xw.z), bflo(xw.w), bfhi(xw.w)};
                f32x4 ao[2], uo[2];
#pragma unroll
                for (int n = 0; n < 2; ++n)
#pragma unroll
                    for (int e = 0; e < 4; ++e) {
                        const int q = n * 4 + e;
                        const float r = sigmoidf_(acc[ai][0][m][n][e] + bav[q]), ig = sigmoidf_(acc[ai][1][m][n][e] + bxv[q]);
                        const float log_a = r * spv[q];
                        ao[n][e] = log_a;
                        uo[n][e] = __builtin_amdgcn_sqrtf(neg_expm1(2.f * log_a)) * (ig * xv[q]);
                    }
                store8_bf16(a_out + idx, ao[0], ao[1]);
                store8_bf16(u_out + idx, uo[0], uo[1]);
            }
    }
};
}

__device__ void transpose_w(const int wid_s, const int vb, const int nb, const float* __restrict__ W, bf16_t* __restrict__ Wt, int K, int N, float* sm, const int rs_hi = 128, const int rs_off = 0) {
    const int tidx = tid_opaque();
    const int tid = tidx, tn = N / 128, ntile = (K / 64) * tn;
    const int lr = tid >> 5, lc = (tid & 31) * 4;
    for (int tile = vb; tile < ntile; tile += 2 * nb) {
        const int tile2 = tile + nb; const bool two = tile2 < ntile;
        const int k0 = (tile / tn) * 64, n0 = (tile % tn) * 128, k1 = two ? (tile2 / tn) * 64 : k0, n1 = two ? (tile2 % tn) * 128 : n0;
        f32x4 v[8];
#pragma unroll
        for (int i = 0; i < 4; ++i) { v[i] = *(const f32x4*)(W + (size_t)(k0 + lr + 16 * i) * N + n0 + lc); v[4 + i] = *(const f32x4*)(W + (size_t)(k1 + lr + 16 * i) * N + n1 + lc); }
#pragma unroll
        for (int i = 0; i < 4; ++i) {
            float* d = sm + (lr + 16 * i) * 129 + lc;
            d[0] = v[i][0]; d[1] = v[i][1]; d[2] = v[i][2]; d[3] = v[i][3];
            d[64 * 129 + 0] = v[4 + i][0]; d[64 * 129 + 1] = v[4 + i][1]; d[64 * 129 + 2] = v[4 + i][2]; d[64 * 129 + 3] = v[4 + i][3];
        }
        __syncthreads();
#pragma unroll
        for (int h2 = 0; h2 < 2; ++h2) {
            if (h2 == 1 && !two) break;
            const float* sp = sm + h2 * 64 * 129;
            const int n = tid >> 2, kc = (tid & 3) * 16;
            u32x4 w0, w1;
            w0.x = cvt_pk_bf16(sp[(kc + 0) * 129 + n], sp[(kc + 1) * 129 + n]); w0.y = cvt_pk_bf16(sp[(kc + 2) * 129 + n], sp[(kc + 3) * 129 + n]);
            w0.z = cvt_pk_bf16(sp[(kc + 4) * 129 + n], sp[(kc + 5) * 129 + n]); w0.w = cvt_pk_bf16(sp[(kc + 6) * 129 + n], sp[(kc + 7) * 129 + n]);
            w1.x = cvt_pk_bf16(sp[(kc + 8) * 129 + n], sp[(kc + 9) * 129 + n]); w1.y = cvt_pk_bf16(sp[(kc + 10) * 129 + n], sp[(kc + 11) * 129 + n]);
            w1.z = cvt_pk_bf16(sp[(kc + 12) * 129 + n], sp[(kc + 13) * 129 + n]); w1.w = cvt_pk_bf16(sp[(kc + 14) * 129 + n], sp[(kc + 15) * 129 + n]);
            const int nn = (h2 ? n1 : n0) + n, kk0 = h2 ? k1 : k0;
            bf16_t* dp = Wt + (size_t)((nn >> 7) * rs_hi + (nn & 127) + rs_off) * K + kk0 + kc;
            *(u32x4*)dp = w0; *(u32x4*)(dp + 8) = w1;
        }
        __syncthreads();
    }
}

__device__ void rmsnorm_phase(const int wid_s, const float* __restrict__ x, const float* __restrict__ g, bf16_t* __restrict__ out) {
    const int tidx = tid_opaque();
    const int lane = tidx & 63, wv = blockIdx.x * 8 + (tidx >> 6), nw = gridDim.x * 8;
    for (int row = wv; row < T_; row += nw) {
        const float* xr = x + (size_t)row * 2048;
        f32x4 v[8]; float ss = 0.f;
#pragma unroll
        for (int i = 0; i < 8; ++i) { v[i] = *(const f32x4*)(xr + i * 256 + lane * 4); ss += v[i][0] * v[i][0] + v[i][1] * v[i][1] + v[i][2] * v[i][2] + v[i][3] * v[i][3]; }
        ss = wave_sum(ss);
        const float r = rsqrtf(ss * (1.f / 2048.f) + 1e-6f);
#pragma unroll
        for (int i = 0; i < 8; ++i) {
            const f32x4 gg = *(const f32x4*)(g + i * 256 + lane * 4);
            u32x2 w; w.x = cvt_pk_bf16(v[i][0] * r * gg[0], v[i][1] * r * gg[1]); w.y = cvt_pk_bf16(v[i][2] * r * gg[2], v[i][3] * r * gg[3]);
            *(u32x2*)(out + (size_t)row * 2048 + i * 256 + lane * 4) = w;
        }
    }
}

__device__ void conv_phase(const int wid_s, const int vb, const int nb, const bf16_t* __restrict__ proj, const float* __restrict__ w, const float* __restrict__ b, bf16_t* __restrict__ xc) {
    const int tidx = tid_opaque();
    const int gt = vb * NTHR + tidx, ng = nb * NTHR;
    for (int it = gt; it < T_ * 256; it += ng) {
        const int t = it >> 8, c = (it & 255) * 8, s = t & (S_ - 1);
        float y[8];
#pragma unroll
        for (int e = 0; e < 8; ++e) y[e] = b[c + e];
#pragma unroll
        for (int tap = 0; tap < 4; ++tap) {
            if (s - 3 + tap >= 0) {
                const u32x4 xw = *(const u32x4*)(proj + (size_t)(t - 3 + tap) * REC_IN + c);
                const float* wp = w + tap * 2048 + c;
                y[0] += bflo(xw.x) * wp[0]; y[1] += bfhi(xw.x) * wp[1]; y[2] += bflo(xw.y) * wp[2]; y[3] += bfhi(xw.y) * wp[3];
                y[4] += bflo(xw.z) * wp[4]; y[5] += bfhi(xw.z) * wp[5]; y[6] += bflo(xw.w) * wp[6]; y[7] += bfhi(xw.w) * wp[7];
            }
        }
        u32x4 o; o.x = cvt_pk_bf16(y[0], y[1]); o.y = cvt_pk_bf16(y[2], y[3]); o.z = cvt_pk_bf16(y[4], y[5]); o.w = cvt_pk_bf16(y[6], y[7]);
        *(u32x4*)(xc + (size_t)t * 2048 + c) = o;
    }
}

__device__ void scan_a_phase(const int wid_s, const int vb, const int nb, const bf16_t* __restrict__ la, const bf16_t* __restrict__ u, float* __restrict__ sumP, float* __restrict__ sumH) {
    const int tidx = tid_opaque();
    const int gt = vb * NTHR + tidx, ng = nb * NTHR;
    for (int it = gt; it < NB_ * 32 * 512; it += ng) {
        const int c4 = it & 511, ch = (it >> 9) & 31, b = it >> 14;
        const size_t base = ((size_t)(b * S_ + ch * 64)) * 2048 + c4 * 4;
        float sl[4] = {0.f, 0.f, 0.f, 0.f}, h[4] = {0.f, 0.f, 0.f, 0.f};
        for (int s0 = 0; s0 < 64; s0 += 16) {
            u32x2 aw[16], uw[16];
#pragma unroll
            for (int s = 0; s < 16; ++s) { aw[s] = *(const u32x2*)(la + base + (size_t)(s0 + s) * 2048); uw[s] = *(const u32x2*)(u + base + (size_t)(s0 + s) * 2048); }
            __builtin_amdgcn_sched_barrier(0);
#pragma unroll
            for (int s = 0; s < 16; ++s) {
                const float l[4] = {bflo(aw[s].x), bfhi(aw[s].x), bflo(aw[s].y), bfhi(aw[s].y)}, uu[4] = {bflo(uw[s].x), bfhi(uw[s].x), bflo(uw[s].y), bfhi(uw[s].y)};
#pragma unroll
                for (int e = 0; e < 4; ++e) { sl[e] += l[e]; h[e] = __expf(l[e]) * h[e] + uu[e]; }
            }
        }
        const size_t si = ((size_t)(b * 32 + ch)) * 2048 + c4 * 4;
        *(f32x4*)(sumP + si) = (f32x4){__expf(sl[0]), __expf(sl[1]), __expf(sl[2]), __expf(sl[3])}; *(f32x4*)(sumH + si) = (f32x4){h[0], h[1], h[2], h[3]};
    }
}
__device__ void scan_b_phase(const int wid_s, const int vb, const int nb, const bf16_t* __restrict__ la, const bf16_t* __restrict__ u, const float* __restrict__ sumP, const float* __restrict__ sumH,
                             const bf16_t* __restrict__ proj, bf16_t* __restrict__ y) {
    const int tidx = tid_opaque();
    const int gt = vb * NTHR + tidx, ng = nb * NTHR;
    for (int it = gt; it < NB_ * 32 * 512; it += ng) {
        const int c4 = it & 511, ch = (it >> 9) & 31, b = it >> 14;
        const size_t t0 = (size_t)(b * S_ + ch * 64);
        u32x2 aw[16], uw[16], gw[16];
#pragma unroll
        for (int s = 0; s < 16; ++s) { const size_t t = t0 + s; aw[s] = *(const u32x2*)(la + t * 2048 + c4 * 4); uw[s] = *(const u32x2*)(u + t * 2048 + c4 * 4); gw[s] = *(const u32x2*)(proj + t * REC_IN + 2048 + c4 * 4); }
        f32x4 h = (f32x4){0.f, 0.f, 0.f, 0.f};
        for (int j0 = 0; j0 < ch; j0 += 8) {
            f32x4 pv[8], hv[8];
#pragma unroll
            for (int j = 0; j < 8; ++j) { const int jj = (j0 + j < ch) ? j0 + j : ch - 1; const size_t si = ((size_t)(b * 32 + jj)) * 2048 + c4 * 4; pv[j] = *(const f32x4*)(sumP + si); hv[j] = *(const f32x4*)(sumH + si); }
            __builtin_amdgcn_sched_barrier(0);
#pragma unroll
            for (int j = 0; j < 8; ++j) if (j0 + j < ch) h = pv[j] * h + hv[j];
        }
        for (int s0 = 0; s0 < 64; s0 += 16) {
            __builtin_amdgcn_sched_barrier(0);
#pragma unroll
            for (int s = 0; s < 16; ++s) {
                const size_t t = t0 + s0 + s;
                h[0] = __expf(bflo(aw[s].x)) * h[0] + bflo(uw[s].x); h[1] = __expf(bfhi(aw[s].x)) * h[1] + bfhi(uw[s].x);
                h[2] = __expf(bflo(aw[s].y)) * h[2] + bflo(uw[s].y); h[3] = __expf(bfhi(aw[s].y)) * h[3] + bfhi(uw[s].y);
                *(u32x2*)(y + t * REC_OUT + c4 * 4) = (u32x2){cvt_pk_bf16(h[0] * bflo(gw[s].x), h[1] * bfhi(gw[s].x)), cvt_pk_bf16(h[2] * bflo(gw[s].y), h[3] * bfhi(gw[s].y))};
            }
            if (s0 + 16 < 64) {
#pragma unroll
                for (int s = 0; s < 16; ++s) { const size_t t = t0 + s0 + 16 + s; aw[s] = *(const u32x2*)(la + t * 2048 + c4 * 4); uw[s] = *(const u32x2*)(u + t * 2048 + c4 * 4); gw[s] = *(const u32x2*)(proj + t * REC_IN + 2048 + c4 * 4); }
            }
        }
    }
}
__device__ void att_qkv_phase(const int wid_s, bf16_t* __restrict__ proj, const float* __restrict__ qn, const float* __restrict__ kn, const float* __restrict__ ropetab, bf16_t* __restrict__ vT, bf16_t* sm) {
    const int tidx = tid_opaque();
    const int lane = tidx & 63, wv = blockIdx.x * 8 + (tidx >> 6), nw = gridDim.x * 8, j = lane & 15, gq = lane >> 4;
    float qw[8], kw8[8];
#pragma unroll
    for (int e = 0; e < 8; ++e) { qw[e] = qn[8 * j + e]; kw8[e] = kn[8 * j + e]; }
    for (int t = wv; t < T_; t += nw) {
        const int s = t & (S_ - 1);
        float cs[8], sn[8];
        {
            const float* rp = ropetab + s * 32 + (j & 1) * 8;
            const f32x4 c0 = *(const f32x4*)rp, c1 = *(const f32x4*)(rp + 4), s0 = *(const f32x4*)(rp + 16), s1 = *(const f32x4*)(rp + 20);
#pragma unroll
            for (int e = 0; e < 4; ++e) { cs[e] = c0[e]; cs[4 + e] = c1[e]; sn[e] = s0[e]; sn[4 + e] = s1[e]; }
        }
        bf16_t* row = proj + (size_t)t * ATT_IN + gq * 128 + 8 * j;
        u32x4 w[8];
#pragma unroll
        for (int c = 0; c < 8; ++c) w[c] = *(const u32x4*)(row + c * 512);
#pragma unroll
        for (int c = 0; c < 8; ++c) {
            float v[8] = {bflo(w[c].x), bfhi(w[c].x), bflo(w[c].y), bfhi(w[c].y), bflo(w[c].z), bfhi(w[c].z), bflo(w[c].w), bfhi(w[c].w)};
            float ss = 0.f;
#pragma unroll
            for (int e = 0; e < 8; ++e) ss += v[e] * v[e];
            ss += __shfl_xor(ss, 1); ss += __shfl_xor(ss, 2); ss += __shfl_xor(ss, 4); ss += __shfl_xor(ss, 8);
            const float r = rsqrtf(ss * (1.f / 128.f) + 1e-6f) * (c < 4 ? 0.12751743f : 1.f);
#pragma unroll
            for (int e = 0; e < 8; ++e) v[e] = v[e] * (c < 4 ? qw[e] : kw8[e]);
#pragma unroll
            for (int e = 0; e < 8; ++e) {
                const float o = __shfl_xor(v[e], 2);
                const float rot = j < 2 ? v[e] * cs[e] - o * sn[e] : v[e] * cs[e] + o * sn[e];
                v[e] = (j < 4 ? rot : v[e]) * r;
            }
            u32x4 o4; o4.x = cvt_pk_bf16(v[0], v[1]); o4.y = cvt_pk_bf16(v[2], v[3]); o4.z = cvt_pk_bf16(v[4], v[5]); o4.w = cvt_pk_bf16(v[6], v[7]);
            *(u32x4*)(row + c * 512) = o4;
        }
    }
    const int tid = tidx;
    for (int tile = blockIdx.x; tile < NB_ * 8 * 32 * 4; tile += gridDim.x) {
        const int vq = tile & 3, sb = (tile >> 2) & 31, hd = (tile >> 7) & 7, b = tile >> 10;
        {
            const int tok = tid >> 3, vc = (tid & 7) * 8;
            const u32x4 w = *(const u32x4*)(proj + ((size_t)(b * S_ + sb * 64 + tok)) * ATT_IN + 4096 + hd * 256 + vq * 64 + vc);
            *(u32x4*)(sm + tok * 72 + vc) = w;
        }
        __syncthreads();
        {
            const int vv = tid >> 3, tc = (tid & 7) * 8;
            unsigned short e[8];
#pragma unroll
            for (int i = 0; i < 8; ++i) e[i] = sm[(tc + i) * 72 + vv];
            u32x4 w; w.x = e[0] | ((unsigned)e[1] << 16); w.y = e[2] | ((unsigned)e[3] << 16); w.z = e[4] | ((unsigned)e[5] << 16); w.w = e[6] | ((unsigned)e[7] << 16);
            *(u32x4*)(vT + (((size_t)(b * 8 + hd)) * 256 + vq * 64 + vv) * S_ + sb * 64 + tc) = w;
        }
        __syncthreads();
    }
}

constexpr int HG_Q1 = 0, HG_Q2 = 17408, HG_K1 = 34816, HG_K2T = 52224, HG_VT = 70656, HG_P = 75264, HG_ST = 84480, HG_DEC = 93184, HG_TOT = 93696, HG_END = 97792;
static_assert(HG_END <= LDS_BYTES, "hgrn LDS");
__device__ __forceinline__ bf16x8 ldfrag(const LAS unsigned char* p) { return *(const LAS bf16x8*)p; }
__device__ __forceinline__ unsigned short bf1(float x) { return (unsigned short)(cvt_pk_bf16(x, 0.f) & 0xffffu); }


constexpr int HF_Q1 = 0, HF_Q2 = 17408, HF_K1 = 34816, HF_K2T = 52224, HF_VT = 70656, HF_P = 89088, HF_ST = 98304, HF_DEC = 133120, HF_TOT = 133632, HF_SSQ = 137728, HF_END = 138240;
static_assert(HF_END <= LDS_BYTES - 16, "hgrn full LDS");
template <int NVT>
__device__ void hgrn_full_phase(const int wid_s, const int item, const bf16_t* __restrict__ proj, const float* __restrict__ logfb, bf16_t* __restrict__ oraw,
                                const float* __restrict__ gon, bf16_t* __restrict__ y, LAS unsigned char* lds) {
    const int lane = lane_fresh(), tid = wid_s * 64 + lane, fr = lane & 15, fq = lane >> 4, w = wid_s;
    const int kp = lane, p8 = wid_s;
    const int b = NVT == 8 ? item >> 4 : item >> 5, hd = NVT == 8 ? item & 15 : (item >> 1) & 15, vs = NVT == 8 ? 0 : item & 1;
    constexpr int VW = 16 * NVT;
    for (int i = tid; i < (HF_DEC - HF_P) / 4; i += NTHR) ((LAS unsigned*)(lds + HF_P))[i] = 0u;
    f32x4 st[NVT];
#pragma unroll
    for (int n = 0; n < NVT; ++n) st[n] = (f32x4){0.f, 0.f, 0.f, 0.f};
    const float* lfp = logfb + ((size_t)(b * S_ + 8 * p8)) * 2048 + hd * 128 + 2 * kp;
    const bf16_t* qp = proj + ((size_t)(b * S_ + 8 * p8)) * REC_IN + 4096 + hd * 128 + 2 * kp;
    const bf16_t* vp = proj + ((size_t)(b * S_ + lane)) * REC_IN + 8192 + hd * 128 + vs * VW + w * (2 * NVT);
    f32x2 lfr[8]; unsigned qr[8], kr[8]; u32x4 vr0, vr1;
#pragma unroll
    for (int i = 0; i < 8; ++i) { lfr[i] = *(const f32x2*)(lfp + (size_t)i * 2048); qr[i] = *(const unsigned*)(qp + (size_t)i * REC_IN); kr[i] = *(const unsigned*)(qp + (size_t)i * REC_IN + 2048); }
    vr0 = *(const u32x4*)vp; vr1 = vr0; if (NVT == 8) vr1 = *(const u32x4*)(vp + 8);
    f32x4 ggh[NVT / 2];
#pragma unroll
    for (int q = 0; q < NVT / 2; ++q) ggh[q] = *(const f32x4*)(gon + 16 * ((w & 1) * (NVT / 2) + q) + 4 * fq);
    __syncthreads();
    for (int c = 0; c < 32; ++c) {
        f32x2 bl[8]; f32x2 cum = (f32x2){0.f, 0.f};
#pragma unroll
        for (int i = 0; i < 8; ++i) { cum += lfr[i]; bl[i] = cum; }
        *(LAS f32x2*)(lds + HF_TOT + (p8 * 128 + 2 * kp) * 4) = cum;
        __syncthreads();
        f32x2 off = (f32x2){0.f, 0.f}, bmid = (f32x2){0.f, 0.f}, blast = (f32x2){0.f, 0.f};
#pragma unroll
        for (int pp = 0; pp < 8; ++pp) {
            const f32x2 tv = *(const LAS f32x2*)(lds + HF_TOT + (pp * 128 + 2 * kp) * 4);
            if (pp < p8) off += tv;
            if (pp < 4) bmid += tv;
            blast += tv;
        }
        if (p8 == 0) *(LAS f32x2*)(lds + HF_DEC + 2 * kp * 4) = (f32x2){__builtin_amdgcn_exp2f(blast[0]), __builtin_amdgcn_exp2f(blast[1])};
        const f32x2 ek = (f32x2){__builtin_amdgcn_exp2f(blast[0] - bmid[0]), __builtin_amdgcn_exp2f(blast[1] - bmid[1])};
        float k2a[8], k2b[8];
#pragma unroll
        for (int i = 0; i < 8; ++i) {
            const int t = 8 * p8 + i;
            const f32x2 bq = off + bl[i];
            const float x0 = bq[0] - bmid[0], x1 = bq[1] - bmid[1];
            const float q0v = bflo(qr[i]), q1v = bfhi(qr[i]), k0v = bflo(kr[i]), k1v = bfhi(kr[i]);
            const float qa = q0v * __builtin_amdgcn_exp2f(fminf(x0, 115.f)), qb2 = q1v * __builtin_amdgcn_exp2f(fminf(x1, 115.f));
            const float ka = k0v * __builtin_amdgcn_exp2f(fminf(-x0, 115.f)), kb2 = k1v * __builtin_amdgcn_exp2f(fminf(-x1, 115.f));
            *(LAS unsigned*)(lds + HF_Q1 + t * 272 + kp * 4) = cvt_pk_bf16(qa, qb2);
            *(LAS unsigned*)(lds + HF_Q2 + t * 272 + kp * 4) = cvt_pk_bf16(q0v * __builtin_amdgcn_exp2f(bq[0]), q1v * __builtin_amdgcn_exp2f(bq[1]));
            *(LAS unsigned*)(lds + HF_K1 + t * 272 + kp * 4) = cvt_pk_bf16(ka, kb2);
            k2a[i] = ka * ek[0]; k2b[i] = kb2 * ek[1];
        }
        *(LAS u32x4*)(lds + HF_K2T + (2 * kp) * 144 + p8 * 16) = (u32x4){cvt_pk_bf16(k2a[0], k2a[1]), cvt_pk_bf16(k2a[2], k2a[3]), cvt_pk_bf16(k2a[4], k2a[5]), cvt_pk_bf16(k2a[6], k2a[7])};
        *(LAS u32x4*)(lds + HF_K2T + (2 * kp + 1) * 144 + p8 * 16) = (u32x4){cvt_pk_bf16(k2b[0], k2b[1]), cvt_pk_bf16(k2b[2], k2b[3]), cvt_pk_bf16(k2b[4], k2b[5]), cvt_pk_bf16(k2b[6], k2b[7])};
        {
            const int sv = lane, vv0 = w * (2 * NVT);
            const unsigned vw[8] = {vr0.x, vr0.y, vr0.z, vr0.w, vr1.x, vr1.y, vr1.z, vr1.w};
#pragma unroll
            for (int e = 0; e < NVT; ++e) {
                *(LAS unsigned short*)(lds + HF_VT + (vv0 + 2 * e) * 144 + sv * 2) = (unsigned short)(vw[e] & 0xffffu);
                *(LAS unsigned short*)(lds + HF_VT + (vv0 + 2 * e + 1) * 144 + sv * 2) = (unsigned short)(vw[e] >> 16);
            }
        }
        if (c + 1 < 32) {
            const size_t to = (size_t)(64 * (c + 1));
#pragma unroll
            for (int i = 0; i < 8; ++i) { lfr[i] = *(const f32x2*)(lfp + (to + i) * 2048); qr[i] = *(const unsigned*)(qp + (to + i) * REC_IN); kr[i] = *(const unsigned*)(qp + (to + i) * REC_IN + 2048); }
            vr0 = *(const u32x4*)(vp + to * REC_IN); if (NVT == 8) vr1 = *(const u32x4*)(vp + to * REC_IN + 8);
        }
        __syncthreads();
        for (int idx = w; idx < 10; idx += 8) {
            const int nt = idx >= 6 ? 3 : (idx >= 3 ? 2 : (idx >= 1 ? 1 : 0)), ms = idx - (nt * (nt + 1)) / 2;
            bf16x8 fa[4], fb[4];
#pragma unroll
            for (int ks = 0; ks < 4; ++ks) { fa[ks] = ldfrag(lds + HF_K1 + (16 * ms + fr) * 272 + 64 * ks + 16 * fq); fb[ks] = ldfrag(lds + HF_Q1 + (16 * nt + fr) * 272 + 64 * ks + 16 * fq); }
            __builtin_amdgcn_sched_barrier(0);
            f32x4 acc = (f32x4){0.f, 0.f, 0.f, 0.f}, acc2 = (f32x4){0.f, 0.f, 0.f, 0.f};
            acc = __builtin_amdgcn_mfma_f32_16x16x32_bf16(fa[0], fb[0], acc, 0, 0, 0);
            acc2 = __builtin_amdgcn_mfma_f32_16x16x32_bf16(fa[1], fb[1], acc2, 0, 0, 0);
            acc = __builtin_amdgcn_mfma_f32_16x16x32_bf16(fa[2], fb[2], acc, 0, 0, 0);
            acc2 = __builtin_amdgcn_mfma_f32_16x16x32_bf16(fa[3], fb[3], acc2, 0, 0, 0);
            acc += acc2;
            if (ms == nt) {
#pragma unroll
                for (int e = 0; e < 4; ++e) if (4 * fq + e > fr) acc[e] = 0.f;
            }
            *(LAS u32x2*)(lds + HF_P + (16 * nt + fr) * 144 + (16 * ms + 4 * fq) * 2) = (u32x2){cvt_pk_bf16_v(acc[0], acc[1]), cvt_pk_bf16_v(acc[2], acc[3])};
        }
        __syncthreads();
        f32x4 oacc[NVT / 2]; u32x2 gatew[NVT / 2];
        const int tt = w >> 1;
        {
            bf16x8 fb[6];
#pragma unroll
            for (int ks = 0; ks < 2; ++ks) fb[ks] = ldfrag(lds + HF_P + (16 * tt + fr) * 144 + 64 * ks + 16 * fq);
#pragma unroll
            for (int ks = 0; ks < 4; ++ks) fb[2 + ks] = ldfrag(lds + HF_Q2 + (16 * tt + fr) * 272 + 64 * ks + 16 * fq);
            if (NVT == 8) {
#pragma unroll
                for (int q = 0; q < NVT / 2; ++q)
                    gatew[q] = *(const u32x2*)(proj + ((size_t)(b * S_ + 64 * c + 16 * tt + fr)) * REC_IN + 10240 + hd * 128 + 16 * ((w & 1) * (NVT / 2) + q) + 4 * fq);
            }
#pragma unroll
            for (int q = 0; q < NVT / 2; ++q) {
                const int vt = (w & 1) * (NVT / 2) + q;
                bf16x8 fa[6];
#pragma unroll
                for (int ks = 0; ks < 2; ++ks) fa[ks] = ldfrag(lds + HF_VT + (16 * vt + fr) * 144 + 64 * ks + 16 * fq);
#pragma unroll
                for (int ks = 0; ks < 4; ++ks) fa[2 + ks] = ldfrag(lds + HF_ST + (16 * vt + fr) * 272 + 64 * ks + 16 * fq);
                __builtin_amdgcn_sched_barrier(0);
                f32x4 acc = (f32x4){0.f, 0.f, 0.f, 0.f}, acc2 = (f32x4){0.f, 0.f, 0.f, 0.f};
                acc = __builtin_amdgcn_mfma_f32_16x16x32_bf16(fa[0], fb[0], acc, 0, 0, 0);
                acc2 = __builtin_amdgcn_mfma_f32_16x16x32_bf16(fa[2], fb[2], acc2, 0, 0, 0);
                acc = __builtin_amdgcn_mfma_f32_16x16x32_bf16(fa[1], fb[1], acc, 0, 0, 0);
                acc2 = __builtin_amdgcn_mfma_f32_16x16x32_bf16(fa[3], fb[3], acc2, 0, 0, 0);
                acc = __builtin_amdgcn_mfma_f32_16x16x32_bf16(fa[4], fb[4], acc, 0, 0, 0);
                acc2 = __builtin_amdgcn_mfma_f32_16x16x32_bf16(fa[5], fb[5], acc2, 0, 0, 0);
                acc += acc2;
                if (NVT == 8) oacc[q] = acc;
                else *(u32x2*)(oraw + ((size_t)(b * S_ + 64 * c + 16 * tt + fr)) * 2048 + hd * 128 + vs * VW + 16 * vt + 4 * fq) = (u32x2){cvt_pk_bf16_v(acc[0], acc[1]), cvt_pk_bf16_v(acc[2], acc[3])};
            }
            if (NVT == 8) {
                float ps = 0.f;
#pragma unroll
                for (int q = 0; q < NVT / 2; ++q) ps += oacc[q][0] * oacc[q][0] + oacc[q][1] * oacc[q][1] + oacc[q][2] * oacc[q][2] + oacc[q][3] * oacc[q][3];
                ps += __shfl_xor(ps, 16); ps += __shfl_xor(ps, 32);
                if (fq == 0) ((LAS float*)(lds + HF_SSQ))[(w & 1) * 64 + 16 * tt + fr] = ps;
            }
            bf16x8 ka[2];
#pragma unroll
            for (int ks = 0; ks < 2; ++ks) ka[ks] = ldfrag(lds + HF_K2T + (16 * w + fr) * 144 + 64 * ks + 16 * fq);
            const f32x4 dv = *(const LAS f32x4*)(lds + HF_DEC + (16 * w + 4 * fq) * 4);
#pragma unroll
            for (int n = 0; n < NVT; n += 2) {
                bf16x8 vb2[4];
#pragma unroll
                for (int ks = 0; ks < 2; ++ks) { vb2[ks] = ldfrag(lds + HF_VT + (16 * n + fr) * 144 + 64 * ks + 16 * fq); vb2[2 + ks] = ldfrag(lds + HF_VT + (16 * n + 16 + fr) * 144 + 64 * ks + 16 * fq); }
                __builtin_amdgcn_sched_barrier(0);
                f32x4 s0 = st[n] * dv, s1 = st[n + 1] * dv;
                s0 = __builtin_amdgcn_mfma_f32_16x16x32_bf16(ka[0], vb2[0], s0, 0, 0, 0);
                s1 = __builtin_amdgcn_mfma_f32_16x16x32_bf16(ka[0], vb2[2], s1, 0, 0, 0);
                s0 = __builtin_amdgcn_mfma_f32_16x16x32_bf16(ka[1], vb2[1], s0, 0, 0, 0);
                s1 = __builtin_amdgcn_mfma_f32_16x16x32_bf16(ka[1], vb2[3], s1, 0, 0, 0);
                st[n] = s0; st[n + 1] = s1;
            }
        }
        __syncthreads();
        if (NVT == 8) {
            const float ssq = ((LAS float*)(lds + HF_SSQ))[16 * tt + fr] + ((LAS float*)(lds + HF_SSQ))[64 + 16 * tt + fr];
            const float rstd = rsqrtf(ssq * (1.f / 128.f) + 1e-6f);
#pragma unroll
            for (int q = 0; q < NVT / 2; ++q) {
                const int vv = 16 * ((w & 1) * (NVT / 2) + q) + 4 * fq;
                const f32x4 gg = ggh[q];
                const f32x4 o4 = oacc[q] * rstd * gg;
                *(u32x2*)(y + ((size_t)(b * S_ + 64 * c + 16 * tt + fr)) * REC_OUT + 2048 + hd * 128 + vv) =
                    (u32x2){cvt_pk_bf16_v(o4[0] * bflo(gatew[q].x), o4[1] * bfhi(gatew[q].x)), cvt_pk_bf16_v(o4[2] * bflo(gatew[q].y), o4[3] * bfhi(gatew[q].y))};
            }
        }
#pragma unroll
        for (int n = 0; n < NVT; ++n)
            *(LAS u32x2*)(lds + HF_ST + (16 * n + fr) * 272 + (16 * w + 4 * fq) * 2) = (u32x2){cvt_pk_bf16_v(st[n][0], st[n][1]), cvt_pk_bf16_v(st[n][2], st[n][3])};
    }
    __syncthreads();
}

__device__ __forceinline__ float xhalf_max(float x) { const auto r = __builtin_amdgcn_permlane32_swap(__float_as_uint(x), __float_as_uint(x), false, false); return fmaxf(__uint_as_float(r[0]), __uint_as_float(r[1])); }
__device__ __forceinline__ float xhalf_sum(float x) { const auto r = __builtin_amdgcn_permlane32_swap(__float_as_uint(x), __float_as_uint(x), false, false); return __uint_as_float(r[0]) + __uint_as_float(r[1]); }
typedef float f32x16 __attribute__((ext_vector_type(16)));
constexpr int AT_KROW = 272, AT_VROW = 72, AT_K2 = 32 * AT_KROW, AT_VT = 2 * AT_K2, AT_STAGE = AT_VT + 256 * AT_VROW;
constexpr int AT_Q = 2 * AT_STAGE;
static_assert(AT_Q + 8 * 32 * AT_KROW <= LDS_BYTES, "attention LDS");

__device__ void attn_phase(const int wid_s, const bf16_t* __restrict__ proj, const bf16_t* __restrict__ vT, const float* __restrict__ lamp, const float* __restrict__ gsub, const float mul,
                           bf16_t* __restrict__ y, LAS unsigned char* lds) {
    const int lane0 = lane_fresh(), rg = wid_s & 3, map = wid_s >> 2;
    const float lam = lamp[0];
    for (int pair = blockIdx.x; pair < 256; pair += gridDim.x) {
        const int pr = (gridDim.x == 256) ? ((pair & 7) * 32 + (pair >> 3)) : pair;
        const int qa = pr & 7, hd = (pr >> 3) & 7, b = pr >> 6;
        for (int half = 0; half < 2; ++half) {
            const int qb = half ? qa : 15 - qa;
            int lane = lane0; asm volatile("" : "+v"(lane));
            const int tid = wid_s * 64 + lane, r = lane & 31, h = lane >> 5;
            const int q0 = qb * 128 + rg * 32;
            const int nsteps = (qb + 1) * 4, mysteps = (q0 >> 5) + 1;
            const LAS unsigned char* qb_l = lds + AT_Q + wid_s * (32 * AT_KROW) + r * AT_KROW + 16 * h;
            {
                const int qr = lane >> 1, qc = (lane & 1) * 8;
                const bf16_t* qp = proj + ((size_t)(b * S_ + q0 + qr)) * ATT_IN + hd * 256 + map * 128 + qc * 8;
                LAS unsigned char* qw = lds + AT_Q + wid_s * (32 * AT_KROW) + qr * AT_KROW + qc * 16;
#pragma unroll
                for (int c = 0; c < 8; ++c) *(LAS u32x4*)(qw + c * 16) = *(const u32x4*)(qp + c * 8);
            }
            f32x16 o[8];
#pragma unroll
            for (int mt = 0; mt < 8; ++mt)
#pragma unroll
                for (int e = 0; e < 16; ++e) o[mt][e] = 0.f;
            float m = -INFINITY, l = 0.f;
            const bf16_t* kgb = proj + ((size_t)(b * S_)) * ATT_IN + 2048 + hd * 256;
            const bf16_t* vgb = vT + (((size_t)(b * 8 + hd)) * 256) * S_;
            const unsigned kgo = (unsigned)(tid >> 4) * ATT_IN + (tid & 15) * 8, vgo = (unsigned)(tid >> 2) * S_ + (tid & 3) * 8;
            const int kw = (tid >> 4) * AT_KROW + (tid & 15) * 16;
            const int vw = AT_VT + (tid >> 2) * AT_VROW + (tid & 3) * 16;
            u32x4 rk1, rk2, rv0, rv1;
            rk1 = *(const u32x4*)(kgb + kgo); rk2 = *(const u32x4*)(kgb + 128 + kgo); rv0 = *(const u32x4*)(vgb + vgo); rv1 = *(const u32x4*)(vgb + (size_t)128 * S_ + vgo);
            *(LAS u32x4*)(lds + kw) = rk1; *(LAS u32x4*)(lds + AT_K2 + kw) = rk2;
            *(LAS u32x2*)(lds + vw) = (u32x2){rv0.x, rv0.y}; *(LAS u32x2*)(lds + vw + 8) = (u32x2){rv0.z, rv0.w};
            *(LAS u32x2*)(lds + vw + 128 * AT_VROW) = (u32x2){rv1.x, rv1.y}; *(LAS u32x2*)(lds + vw + 128 * AT_VROW + 8) = (u32x2){rv1.z, rv1.w};
            __syncthreads();
            for (int i = 0; i < nsteps; ++i) {
                const int cur = (i & 1) * AT_STAGE, nxt = AT_STAGE - cur;
                const bool more = (i + 1 < nsteps);
                if (more) {
                    const bf16_t* kgi = kgb + (size_t)(32 * (i + 1)) * ATT_IN; const bf16_t* vgi = vgb + 32 * (i + 1);
                    rk1 = *(const u32x4*)(kgi + kgo); rk2 = *(const u32x4*)(kgi + 128 + kgo);
                    rv0 = *(const u32x4*)(vgi + vgo); rv1 = *(const u32x4*)(vgi + (size_t)128 * S_ + vgo);
                }
                if (i < mysteps) {
                    f32x16 st;
#pragma unroll
                    for (int e = 0; e < 16; ++e) st[e] = 0.f;
                    const LAS unsigned char* kb = lds + cur + map * AT_K2 + r * AT_KROW + 16 * h;
                    const LAS unsigned char* vb = lds + cur + AT_VT + r * AT_VROW + 8 * h;
                    {
                        bf16x8 kfa[4], qfa[4];
#pragma unroll
                        for (int e = 0; e < 4; ++e) { kfa[e] = *(const LAS bf16x8*)(kb + 32 * e); qfa[e] = *(const LAS bf16x8*)(qb_l + 32 * e); }
                        __builtin_amdgcn_sched_barrier(0);
                        f32x16 st2;
#pragma unroll
                        for (int e = 0; e < 16; ++e) st2[e] = 0.f;
                        st = __builtin_amdgcn_mfma_f32_32x32x16_bf16(kfa[0], qfa[0], st, 0, 0, 0);
                        st2 = __builtin_amdgcn_mfma_f32_32x32x16_bf16(kfa[1], qfa[1], st2, 0, 0, 0);
                        st = __builtin_amdgcn_mfma_f32_32x32x16_bf16(kfa[2], qfa[2], st, 0, 0, 0);
                        st2 = __builtin_amdgcn_mfma_f32_32x32x16_bf16(kfa[3], qfa[3], st2, 0, 0, 0);
#pragma unroll
                        for (int e = 0; e < 4; ++e) { kfa[e] = *(const LAS bf16x8*)(kb + 32 * (4 + e)); qfa[e] = *(const LAS bf16x8*)(qb_l + 32 * (4 + e)); }
                        __builtin_amdgcn_sched_barrier(0);
                        st = __builtin_amdgcn_mfma_f32_32x32x16_bf16(kfa[0], qfa[0], st, 0, 0, 0);
                        st2 = __builtin_amdgcn_mfma_f32_32x32x16_bf16(kfa[1], qfa[1], st2, 0, 0, 0);
                        st = __builtin_amdgcn_mfma_f32_32x32x16_bf16(kfa[2], qfa[2], st, 0, 0, 0);
                        st2 = __builtin_amdgcn_mfma_f32_32x32x16_bf16(kfa[3], qfa[3], st2, 0, 0, 0);
                        __builtin_amdgcn_sched_barrier(0);
#pragma unroll
                        for (int e = 0; e < 16; ++e) st[e] += st2[e];
                    }
                    u32x4 vfa[4];
#define AT_LDV(dst, mt, s2) do { const u32x2 _a0 = *(const LAS u32x2*)(vb + (mt) * 32 * AT_VROW + 32 * (s2)), _a1 = *(const LAS u32x2*)(vb + (mt) * 32 * AT_VROW + 32 * (s2) + 16); dst = (u32x4){_a0.x, _a0.y, _a1.x, _a1.y}; } while (0)
                    AT_LDV(vfa[0], 0, 0); AT_LDV(vfa[1], 1, 0); AT_LDV(vfa[2], 0, 1); AT_LDV(vfa[3], 1, 1);
                    __builtin_amdgcn_sched_barrier(0);
                    if (i == mysteps - 1) {
#pragma unroll
                        for (int e = 0; e < 16; ++e) { const int kk = (e & 3) + 8 * (e >> 2) + 4 * h; if (kk > r) st[e] = -INFINITY; }
                    }
                    float mloc = st[0];
#pragma unroll
                    for (int e = 1; e < 16; ++e) mloc = fmaxf(mloc, st[e]);
                    mloc = xhalf_max(mloc);
                    const float mnew = fmaxf(m, mloc);
                    if (__any(mloc - m > 8.f)) {
                        const float alpha = __builtin_amdgcn_exp2f(m - mnew);
                        l *= alpha;
#pragma unroll
                        for (int mt = 0; mt < 8; ++mt)
#pragma unroll
                            for (int e = 0; e < 16; ++e) o[mt][e] *= alpha;
                        m = mnew;
                    }
                    bf16x8 pf[2];
#pragma unroll
                    for (int s2 = 0; s2 < 2; ++s2) {
                        float pe[8];
#pragma unroll
                        for (int e = 0; e < 8; ++e) { pe[e] = __builtin_amdgcn_exp2f(st[8 * s2 + e] - m); l += pe[e]; }
                        u32x4 pw; pw.x = cvt_pk_bf16(pe[0], pe[1]); pw.y = cvt_pk_bf16(pe[2], pe[3]); pw.z = cvt_pk_bf16(pe[4], pe[5]); pw.w = cvt_pk_bf16(pe[6], pe[7]);
                        pf[s2] = __builtin_bit_cast(bf16x8, pw);
                    }
                    __builtin_amdgcn_sched_barrier(0);
#pragma unroll
                    for (int g = 0; g < 4; ++g) {
                        o[2 * g] = __builtin_amdgcn_mfma_f32_32x32x16_bf16(__builtin_bit_cast(bf16x8, vfa[0]), pf[0], o[2 * g], 0, 0, 0);
                        o[2 * g + 1] = __builtin_amdgcn_mfma_f32_32x32x16_bf16(__builtin_bit_cast(bf16x8, vfa[1]), pf[0], o[2 * g + 1], 0, 0, 0);
                        o[2 * g] = __builtin_amdgcn_mfma_f32_32x32x16_bf16(__builtin_bit_cast(bf16x8, vfa[2]), pf[1], o[2 * g], 0, 0, 0);
                        o[2 * g + 1] = __builtin_amdgcn_mfma_f32_32x32x16_bf16(__builtin_bit_cast(bf16x8, vfa[3]), pf[1], o[2 * g + 1], 0, 0, 0);
                        if (g < 3) { AT_LDV(vfa[0], 2 * g + 2, 0); AT_LDV(vfa[1], 2 * g + 3, 0); AT_LDV(vfa[2], 2 * g + 2, 1); AT_LDV(vfa[3], 2 * g + 3, 1); }
                        __builtin_amdgcn_sched_barrier(0);
                    }
#undef AT_LDV
                }
                if (more) {
                    *(LAS u32x4*)(lds + nxt + kw) = rk1; *(LAS u32x4*)(lds + nxt + AT_K2 + kw) = rk2;
                    *(LAS u32x2*)(lds + nxt + vw) = (u32x2){rv0.x, rv0.y}; *(LAS u32x2*)(lds + nxt + vw + 8) = (u32x2){rv0.z, rv0.w};
                    *(LAS u32x2*)(lds + nxt + vw + 128 * AT_VROW) = (u32x2){rv1.x, rv1.y}; *(LAS u32x2*)(lds + nxt + vw + 128 * AT_VROW + 8) = (u32x2){rv1.z, rv1.w};
                }
                __syncthreads();
            }
            l = xhalf_sum(l);
            int r2 = r, h2 = h; asm volatile("" : "+v"(r2), "+v"(h2));
            LAS float* ex = (LAS float*)lds + rg * 8192 + lane;
            if (map == 1) {
                const float sc = lam / l;
#pragma unroll
                for (int mt = 0; mt < 8; ++mt)
#pragma unroll
                    for (int e = 0; e < 16; ++e) ex[(mt * 16 + e) * 64] = o[mt][e] * sc;
            }
            __syncthreads();
            if (map == 0) {
                const float inv = 1.f / l;
                float ssq = 0.f;
#pragma unroll
                for (int mt = 0; mt < 8; ++mt)
#pragma unroll
                    for (int e = 0; e < 16; ++e) { const float v = o[mt][e] * inv - ex[(mt * 16 + e) * 64]; o[mt][e] = v; ssq += v * v; }
                ssq = xhalf_sum(ssq);
                const float rstd = rsqrtf(ssq * (1.f / 256.f) + 1e-5f) * mul;
                const size_t t = (size_t)(b * S_ + q0 + r2);
                const bf16_t* gp = proj + t * ATT_IN + 6144 + hd * 256 + 4 * h2;
                bf16_t* yp = y + t * 2048 + hd * 256 + 4 * h2;
                const float* gs = gsub + 4 * h2;
#pragma unroll
                for (int mt = 0; mt < 8; ++mt)
#pragma unroll
                    for (int g4 = 0; g4 < 4; ++g4) {
                        const int v0 = 32 * mt + 8 * g4;
                        const u32x2 gw = *(const u32x2*)(gp + v0);
                        const f32x4 gg = *(const f32x4*)(gs + v0);
                        u32x2 ow;
                        ow.x = cvt_pk_bf16(o[mt][4 * g4 + 0] * rstd * gg[0] * bflo(gw.x), o[mt][4 * g4 + 1] * rstd * gg[1] * bfhi(gw.x));
                        ow.y = cvt_pk_bf16(o[mt][4 * g4 + 2] * rstd * gg[2] * bflo(gw.y), o[mt][4 * g4 + 3] * rstd * gg[3] * bfhi(gw.y));
                        *(u32x2*)(yp + v0) = ow;
                    }
            }
            __syncthreads();
        }
    }
}


#define XB_TMO      128
#define XB_XCNT(j)  (256  + 64 * (j))
#define XB_XSUB(j)  (1280 + 64 * (j))
#define XB_XGEN(j)  (2304 + 64 * (j))
#define XB_TOP      3328
#define XB_TOPGEN   3392
#define XCD_BAR_WORDS 3456
#define XB_SPIN_CAP (1u << 18)
__device__ __forceinline__ unsigned xb_ld(unsigned* p)              { return __hip_atomic_load(p, __ATOMIC_RELAXED, __HIP_MEMORY_SCOPE_AGENT); }
__device__ __forceinline__ unsigned xb_add(unsigned* p, unsigned v) { return __hip_atomic_fetch_add(p, v, __ATOMIC_RELAXED, __HIP_MEMORY_SCOPE_AGENT); }
__device__ __forceinline__ unsigned xb_xcc_id() { return (unsigned)__builtin_amdgcn_s_getreg((3 << 11) | 20) & 0xFu; }
#define XB_SPIN(cond, bar) do { unsigned _sp = 0; while (cond) { __builtin_amdgcn_s_sleep(1); \
    if ((++_sp & 255u) == 0u) { if (xb_ld(&(bar)[XB_TMO])) break; if (_sp > XB_SPIN_CAP) { atomicAdd(&(bar)[XB_TMO], 1u); break; } } } } while (0)
struct XcdBarrier { unsigned* bar; unsigned x; volatile LAS unsigned* st; unsigned total; };
__device__ __forceinline__ XcdBarrier xcd_barrier_post(unsigned* bar, volatile LAS unsigned* st, unsigned total) {
    XcdBarrier b; b.bar = bar; b.x = xb_xcc_id(); b.st = st; b.total = total;
    if (threadIdx.x == 0) (void)xb_add(&bar[XB_XCNT(b.x)], 1u);
    return b;
}
__device__ __forceinline__ void xcd_barrier_complete(unsigned* bar, unsigned x, unsigned G, unsigned& nloc, unsigned& nx) {
    unsigned sum, cnt, mine, sp = 0u;
    for (;;) {
        sum = 0u; cnt = 0u; mine = 0u;
#pragma unroll
        for (unsigned j = 0; j < 16; ++j) { const unsigned c = xb_ld(&bar[XB_XCNT(j)]); sum += c; cnt += (c > 0u) ? 1u : 0u; mine = (j == x) ? c : mine; }
        if (sum == G) break;
        __builtin_amdgcn_s_sleep(1);
        if ((++sp & 255u) == 0u) { if (xb_ld(&bar[XB_TMO])) break; if (sp > XB_SPIN_CAP) { atomicAdd(&bar[XB_TMO], 1u); break; } }
    }
    nloc = mine > 0u ? mine : 1u; nx = cnt > 0u ? cnt : 1u;
}
__device__ __forceinline__ void xcd_barrier(const XcdBarrier& b) {
    asm volatile("s_waitcnt vmcnt(0)" ::: "memory");
    __syncthreads();
    if (threadIdx.x == 0) {
        unsigned* bar = b.bar;
        __builtin_amdgcn_s_waitcnt(0);
        unsigned nloc = b.st[0], nx = b.st[1];
        if (nloc == 0u) { xcd_barrier_complete(bar, b.x, b.total, nloc, nx); b.st[0] = nloc; b.st[1] = nx; }
        const unsigned old = xb_add(&bar[XB_XSUB(b.x)], 1u);
        const unsigned gen = old / nloc;
        if (old + 1u == (gen + 1u) * nloc) {
            __builtin_amdgcn_fence(__ATOMIC_RELEASE, "agent");
            asm volatile("s_waitcnt vmcnt(0)" ::: "memory");
            const unsigned og = xb_add(&bar[XB_TOP], 1u);
            const unsigned tg = og / nx;
            if (og + 1u == (tg + 1u) * nx) xb_add(&bar[XB_TOPGEN], 1u);
            else XB_SPIN(xb_ld(&bar[XB_TOPGEN]) == tg, bar);
            __builtin_amdgcn_fence(__ATOMIC_ACQUIRE, "agent");
            xb_add(&bar[XB_XGEN(b.x)], 1u);
            asm volatile("s_waitcnt vmcnt(0)" ::: "memory");
        } else {
            XB_SPIN(xb_ld(&bar[XB_XGEN(b.x)]) == gen, bar);
            __builtin_amdgcn_fence(__ATOMIC_ACQUIRE, "agent");
            asm volatile("s_waitcnt vmcnt(0)" ::: "memory");
        }
    }
    __syncthreads();
}
constexpr size_t WS_BAR = WS_SMALL + 32768;
constexpr int LDS_BARST = LDS_BYTES - 16;
constexpr size_t WS_BAR2 = WS_BAR + 16384;
static_assert(true, "");
constexpr int NA_BLOCKS = 64;
static_assert(AT_Q + 8 * 32 * AT_KROW <= LDS_BARST && XCD_BAR_WORDS * 4 + 32768 + 16384 <= 65536, "barrier words");

__device__ __forceinline__ int opaque0() { int z = 0; asm volatile("" : "+s"(z)); return z; }
#define PIN(k) (p.in[(k) + opaque0()])
#define WSP(type, off) ((type*)(ws + (off) + (size_t)opaque0()))

__global__ void __launch_bounds__(NTHR, 2) mega(Params p) {
    extern __shared__ __attribute__((aligned(16))) unsigned char lds_raw[];
    LAS unsigned char* lds = (LAS unsigned char*)lds_raw;
    cg::grid_group grid = cg::this_grid();
    unsigned char* ws = p.ws;
    const int G = gridDim.x;
    const int wid_s = __builtin_amdgcn_readfirstlane(threadIdx.x >> 6);
    int ph = 0;
    const int lo = p.ph_lo, hi = p.ph_hi;
    volatile LAS unsigned* bst = (volatile LAS unsigned*)(lds + LDS_BARST);
    if (threadIdx.x < 4) bst[threadIdx.x] = 0u;
    __syncthreads();
    XcdBarrier xbar = xcd_barrier_post((unsigned*)(ws + WS_BAR), bst, G);
    XcdBarrier xbarB; xbarB.bar = (unsigned*)(ws + WS_BAR2); xbarB.x = xbar.x; xbarB.st = bst + 2; xbarB.total = G - NA_BLOCKS;
    if ((int)blockIdx.x >= NA_BLOCKS) xbarB = xcd_barrier_post((unsigned*)(ws + WS_BAR2), bst + 2, G - NA_BLOCKS);
#ifndef PROBE_DUP
#define PROBE_DUP 0
#endif
#define PHASE_BEGIN_K(kind) if (ph >= lo && ph < hi) { for (int rep = 0; rep <= ((PROBE_DUP >> (kind)) & 1); ++rep) { if (rep) __syncthreads();
#define PHASE_BEGIN PHASE_BEGIN_K(31)
#define PHASE_END   } if (ph + 1 < hi) { if (hi < 0) grid.sync(); else xcd_barrier(xbar); } } ++ph;

    PHASE_BEGIN_K(0)
        const int tid = tid_opaque();
        transpose_w(wid_s, blockIdx.x, G, PIN(2), WSP(bf16_t, WS_W_REC_IN), 2048, REC_IN, (float*)lds_raw);
        {
            const int mt = blockIdx.x >> 3, vbt = blockIdx.x & 7;
            for (int m = mt; m < 32; m += (G + 7) / 8) {
                const int isx = m & 1, hd = (m >> 1) & 7, j = m >> 4;
                const float* src = (isx ? PIN(7) : PIN(5)) + (size_t)(j * 8 + hd) * 65536;
                transpose_w(wid_s, vbt, 8, src, WSP(bf16_t, WS_W_GATE) + (size_t)(j * 16 + hd * 2) * 65536, 256, 256, (float*)lds_raw, 256, 128 * isx);
            }
        }
        float* lb_all = WSP(float, WS_SMALL); float* lamv = lb_all + 4096;
        if (blockIdx.x == 0) {
            const float* hl = PIN(10);
            for (int c = tid; c < 2048; c += NTHR) {
                const float l0 = hl[c], l1 = hl[2048 + c];
                const float m = fmaxf(l0, l1), e0 = __expf(l0 - m), e1 = __expf(l1 - m);
                const float p0 = e0 / (e0 + e1), p1 = e1 / (e0 + e1);
                lb_all[c] = 0.f; lb_all[2048 + c] = (p0 + p1) - p0;
            }
        }
        if (blockIdx.x == 1 && tid < 128) {
            const int j = tid >> 6, lane = tid & 63;
            const float* lp = PIN(17) + j * 512;
            float a1 = lp[lane] * lp[128 + lane] + lp[lane + 64] * lp[128 + lane + 64];
            float a2 = lp[256 + lane] * lp[384 + lane] + lp[256 + lane + 64] * lp[384 + lane + 64];
            a1 = wave_sum(a1); a2 = wave_sum(a2);
            if (lane == 0) lamv[j] = expf(a1) - expf(a2) + p.lam_init[j];
        }
        {
            float* rt = WSP(float, WS_ROPE);
            for (int i = blockIdx.x * NTHR + tid; i < S_ * 16; i += G * NTHR) {
                const int pos = i >> 4, fi = i & 15;
                const float angf = (float)pos * p.inv_freq[fi];
                const double ang = (double)angf;
                const double kk = rint(ang * 0.15915494309189535);
                const float rr = (float)(ang - kk * 6.283185307179586);
                rt[pos * 32 + fi] = cosf(rr); rt[pos * 32 + 16 + fi] = sinf(rr);
            }
        }
        { float* ssz = WSP(float, WS_SS); for (int i = blockIdx.x * NTHR + tid; i < 3 * T_; i += G * NTHR) ssz[i] = 0.f; }
        rmsnorm_phase(wid_s, PIN(0), PIN(1), WSP(bf16_t, WS_H));
    PHASE_END

    for (int layer = 0; layer < 4; ++layer) {
        const int j = layer >> 1;
        if ((layer & 1) == 0) {
            PHASE_BEGIN_K(1)
                pg8::Gemm g{WSP(bf16_t, WS_H), WSP(bf16_t, WS_W_REC_IN) + (size_t)j * REC_IN * 2048, 2048, 2048}; pg8::StaticOrder S; S.init(T_, REC_IN, G, blockIdx.x);
                pg8::EpiRecIn E{WSP(bf16_t, WS_PROJ), WSP(float, WS_S0), WSP(float, WS_SMALL) + j * 2048, layer == 0 ? (const float*)nullptr : WSP(float, WS_SS) + (size_t)(layer - 1) * T_};
                pg8::gemm_phase(wid_s, lds, g, S, E);
            PHASE_END
            PHASE_BEGIN_K(2)
                if ((int)blockIdx.x < NA_BLOCKS) {
                    hgrn_full_phase<NA_BLOCKS == 64 ? 8 : 4>(wid_s, blockIdx.x, WSP(bf16_t, WS_PROJ), WSP(float, WS_S0), WSP(bf16_t, WS_ORAW), PIN(11) + j * 128, WSP(bf16_t, WS_Y), lds);
                } else {
                    const int vb = blockIdx.x - NA_BLOCKS, nb = G - NA_BLOCKS;
                    bf16_t* hb = WSP(bf16_t, WS_H); bf16_t* proj = WSP(bf16_t, WS_PROJ);
                    bf16_t* lab = WSP(bf16_t, WS_S1); bf16_t* ub = lab + (size_t)T_ * 2048;
                    float* sumP = WSP(float, WS_SUM);
                    conv_phase(wid_s, vb, nb, proj, PIN(3) + j * 4 * 2048, PIN(4) + j * 2048, hb);
                    xcd_barrier(xbarB);
                    {
                        pg8::Gemm g{hb, WSP(bf16_t, WS_W_GATE) + (size_t)j * 16 * 256 * 256, 2048, 256 + opaque0()}; pg8::GateOrder S{nb, vb};
                        pg8::EpiGate E{hb, PIN(6) + j * 2048, PIN(8) + j * 2048, PIN(9) + j * 2048, lab, ub};
                        pg8::gemm_phase(wid_s, lds, g, S, E);
                    }
                    xcd_barrier(xbarB);
                    scan_a_phase(wid_s, vb, nb, lab, ub, sumP, sumP + NB_ * 32 * 2048);
                    xcd_barrier(xbarB);
                    scan_b_phase(wid_s, vb, nb, lab, ub, sumP, sumP + NB_ * 32 * 2048, proj, WSP(bf16_t, WS_Y));
                    __syncthreads();
                    transpose_w(wid_s, vb, nb, PIN(14) + (size_t)j * 2048 * ATT_IN, WSP(bf16_t, WS_W_ATT_IN) + (size_t)j * ATT_IN * 2048, 2048, ATT_IN, (float*)lds_raw);
                    transpose_w(wid_s, vb, nb, PIN(19) + (size_t)j * 2048 * 2048, WSP(bf16_t, WS_W_ATT_OUT) + (size_t)j * 2048 * 2048, 2048, 2048, (float*)lds_raw);
                    if (j == 0) {
                        transpose_w(wid_s, vb, nb, PIN(12), WSP(bf16_t, WS_W_REC_OUT), REC_OUT, 2048, (float*)lds_raw);
                        transpose_w(wid_s, vb, nb, PIN(2) + (size_t)2048 * REC_IN, WSP(bf16_t, WS_W_REC_IN) + (size_t)REC_IN * 2048, 2048, REC_IN, (float*)lds_raw);
                        transpose_w(wid_s, vb, nb, PIN(12) + (size_t)REC_OUT * 2048, WSP(bf16_t, WS_W_REC_OUT) + (size_t)2048 * REC_OUT, REC_OUT, 2048, (float*)lds_raw);
                    }
                }
            PHASE_END
        } else {
            PHASE_BEGIN_K(7)
                pg8::Gemm g{WSP(bf16_t, WS_H), WSP(bf16_t, WS_W_ATT_IN) + (size_t)j * ATT_IN * 2048, 2048, 2048}; pg8::StaticOrder S; S.init(T_, ATT_IN, G, blockIdx.x);
                pg8::EpiAttIn E{WSP(bf16_t, WS_PROJ), WSP(float, WS_SS) + (size_t)(layer - 1) * T_, PIN(15) + j * 128, PIN(16) + j * 128, WSP(float, WS_ROPE), WSP(bf16_t, WS_S0), lds + 131072};
                pg8::gemm_phase(wid_s, lds, g, S, E);
            PHASE_END
            PHASE_BEGIN_K(9)
                                attn_phase(wid_s, WSP(bf16_t, WS_PROJ), WSP(const bf16_t, WS_S0), WSP(float, WS_SMALL) + 4096 + j, PIN(18) + j * 256, 1.f - p.lam_init[j], WSP(bf16_t, WS_Y), lds);
            PHASE_END
        }
        PHASE_BEGIN_K(10)
            const bool rec = (layer & 1) == 0;
            const int Ko = rec ? REC_OUT : 2048;
            float* xbuf = WSP(float, WS_X);
            const float* xres = layer == 0 ? PIN(0) : xbuf;
            float* xdst = layer == 3 ? p.out : xbuf;
            pg8::Gemm g{WSP(bf16_t, WS_Y), rec ? WSP(bf16_t, WS_W_REC_OUT) + (size_t)j * 2048 * REC_OUT : WSP(bf16_t, WS_W_ATT_OUT) + (size_t)j * 2048 * 2048, Ko, Ko}; pg8::StaticOrder S; S.init(T_, 2048, G, blockIdx.x);
            const int nl = layer + 1;
            const float* gn = layer == 3 ? (const float*)nullptr : ((nl & 1) ? PIN(13) + (nl >> 1) * 2048 : PIN(1) + (nl >> 1) * 2048);
            pg8::EpiResid E{xres, xdst, gn, WSP(bf16_t, WS_H), WSP(float, WS_SS) + (size_t)layer * T_};
            pg8::gemm_phase(wid_s, lds, g, S, E);
        PHASE_END
    }
}

constexpr int N_PHASES = 1 + 3 + 3 + 3 + 3;

extern "C" void kernel_launch(void* const* d_in, const int* in_sizes, int n_in, void* d_out, int out_size, void* d_ws, size_t ws_size, hipStream_t stream) {
    static int grid = 0;
    if (grid == 0) {
        if (n_in != 20 || ws_size < WS_END) { fprintf(stderr, "kernel_launch: bad inputs (n_in %d, ws %zu < %zu)\n", n_in, ws_size, (size_t)WS_END); grid = -1; return; }
        int dev = 0, cus = 0, per_cu = 0;
        if (hipGetDevice(&dev) != hipSuccess || hipDeviceGetAttribute(&cus, hipDeviceAttributeMultiprocessorCount, dev) != hipSuccess) { grid = -1; return; }
        if (hipFuncSetAttribute((const void*)mega, hipFuncAttributeMaxDynamicSharedMemorySize, LDS_BYTES) != hipSuccess) { fprintf(stderr, "hipFuncSetAttribute failed\n"); grid = -1; return; }
        if (hipOccupancyMaxActiveBlocksPerMultiprocessor(&per_cu, (const void*)mega, NTHR, LDS_BYTES) != hipSuccess || per_cu < 1) { fprintf(stderr, "occupancy query failed (%d)\n", per_cu); grid = -1; return; }
        grid = cus * per_cu;
        if (grid > 256) grid = 256;
        if (grid != 256) { fprintf(stderr, "kernel_launch: this kernel needs exactly 256 resident workgroups (got %d)\n", grid); grid = -1; return; }
    }
    if (grid < 0) return;
    Params p;
    memset(&p, 0, sizeof(p));
    for (int i = 0; i < 20; ++i) p.in[i] = (const float*)d_in[i];
    p.out = (float*)d_out; p.ws = (unsigned char*)d_ws;
    for (int i = 0; i < 16; ++i) p.inv_freq[i] = (float)pow(500000.0, -(double)(2 * i) / 32.0);
    p.lam_init[0] = (float)(0.8 - 0.6 * exp(-0.3 * 1.0));
    p.lam_init[1] = (float)(0.8 - 0.6 * exp(-0.3 * 3.0));
    p.ph_lo = 0; p.ph_hi = N_PHASES;
    if (hipMemsetAsync((unsigned char*)d_ws + WS_BAR, 0, 16384 + XCD_BAR_WORDS * 4, stream) != hipSuccess) { fprintf(stderr, "memset of barrier words failed\n"); return; }
    void* args[] = {&p};
    hipError_t e = hipLaunchCooperativeKernel((const void*)mega, dim3(grid), dim3(NTHR), args, LDS_BYTES, stream);
    if (e != hipSuccess) fprintf(stderr, "cooperative launch failed: %s (grid %d)\n", hipGetErrorString(e), grid);
}
```

```cpp
#include <hip/hip_runtime.h>
#include <hip/hip_cooperative_groups.h>
#include <cstdio>
#include <cstdint>
#include <cmath>
#include <cstring>
namespace cg = cooperative_groups;

#define LAS __attribute__((address_space(3)))
typedef unsigned short bf16_t;
typedef short bf16x8 __attribute__((ext_vector_type(8)));
typedef float f32x4 __attribute__((ext_vector_type(4)));
typedef float f32x2 __attribute__((ext_vector_type(2)));
typedef unsigned u32x4 __attribute__((ext_vector_type(4)));
typedef unsigned u32x2 __attribute__((ext_vector_type(2)));

constexpr int T_ = 8192, S_ = 2048, NB_ = 4;
constexpr int REC_IN = 12288, REC_OUT = 4096, ATT_IN = 8192;
constexpr int NTHR = 512;
constexpr int LDS_BYTES = 147456;

constexpr size_t SZ_W_REC_IN = (size_t)2 * REC_IN * 2048 * 2, SZ_W_REC_OUT = (size_t)2 * 2048 * REC_OUT * 2, SZ_W_ATT_IN = (size_t)2 * ATT_IN * 2048 * 2,
                 SZ_W_ATT_OUT = (size_t)2 * 2048 * 2048 * 2, SZ_W_GATE = (size_t)2 * 16 * 256 * 256 * 2;
constexpr size_t WS_W_REC_IN = 0, WS_W_REC_OUT = WS_W_REC_IN + SZ_W_REC_IN, WS_W_ATT_IN = WS_W_REC_OUT + SZ_W_REC_OUT, WS_W_ATT_OUT = WS_W_ATT_IN + SZ_W_ATT_IN,
                 WS_W_GATE = WS_W_ATT_OUT + SZ_W_ATT_OUT;
constexpr size_t WS_X = WS_W_GATE + SZ_W_GATE;
constexpr size_t WS_H = WS_X + (size_t)T_ * 2048 * 4;
constexpr size_t WS_PROJ = WS_H + (size_t)T_ * 2048 * 2;
constexpr size_t WS_S0 = WS_PROJ + (size_t)T_ * REC_IN * 2;
constexpr size_t WS_S1 = WS_S0 + (size_t)T_ * 2048 * 4;
constexpr size_t WS_ORAW = WS_S1 + (size_t)T_ * 2048 * 4;
constexpr size_t WS_Y = WS_ORAW + (size_t)T_ * 2048 * 2;
constexpr size_t WS_SUM = WS_Y + (size_t)T_ * REC_OUT * 2;
constexpr size_t WS_SMALL = WS_SUM + (size_t)2 * 4 * 32 * 2048 * 4;
constexpr size_t WS_SS = WS_SMALL + 65536;
constexpr size_t WS_ROPE = WS_SS + (size_t)3 * T_ * 4;
constexpr size_t WS_END = WS_ROPE + (size_t)S_ * 32 * 4;

struct Params {
    const float* in[20];
    float* out;
    unsigned char* ws;
    float inv_freq[16];
    float lam_init[2];
    int ph_lo, ph_hi;
};

__device__ __forceinline__ float bf2f(unsigned v) { return __uint_as_float(v << 16); }
__device__ __forceinline__ unsigned cvt_pk_bf16(float lo, float hi) { unsigned r; asm volatile("v_cvt_pk_bf16_f32 %0, %1, %2" : "=v"(r) : "v"(lo), "v"(hi)); return r; }
typedef __bf16 bf16pair_t __attribute__((ext_vector_type(2)));
__device__ __forceinline__ unsigned cvt_pk_bf16_v(float lo, float hi) { const f32x2 v = {lo, hi}; return __builtin_bit_cast(unsigned, __builtin_convertvector(v, bf16pair_t)); }
__device__ __forceinline__ float bflo(unsigned w) { return __uint_as_float(w << 16); }
__device__ __forceinline__ float bfhi(unsigned w) { return __uint_as_float(w & 0xffff0000u); }
__device__ __forceinline__ float sigmoidf_(float x) { return __builtin_amdgcn_rcpf(1.f + __expf(-x)); }
__device__ __forceinline__ float siluf_(float x) { return x * __builtin_amdgcn_rcpf(1.f + __expf(-x)); }
__device__ __forceinline__ float wave_sum(float v) {
#pragma unroll
    for (int o = 32; o > 0; o >>= 1) v += __shfl_xor(v, o);
    return v;
}
__device__ __forceinline__ float wave_max(float v) {
#pragma unroll
    for (int o = 32; o > 0; o >>= 1) v = fmaxf(v, __shfl_xor(v, o));
    return v;
}

__device__ __forceinline__ float neg_expm1(float y) {
    const float ser = -y * (1.f + y * (0.5f + y * (0.16666667f + y * (0.041666668f + y * 0.0083333338f))));
    return y > -0.25f ? ser : 1.f - __expf(y);
}
__device__ __forceinline__ int lane_fresh() { int l; asm volatile("v_mbcnt_lo_u32_b32 %0, -1, 0\n\tv_mbcnt_hi_u32_b32 %0, -1, %0" : "=v"(l)); return l; }
#define tid_opaque() (wid_s * 64 + lane_fresh())

namespace pg8 {
constexpr int BM = 256, BK = 64, HALF = 128, HTB = HALF * BK * 2, STAGE_BYTES = 8 * HTB, NXCD = 8, WGM = 8;
__host__ __device__ __forceinline__ int lds_byte(int r, int c) { const int st = (r >> 4) * 2 + (c >> 5), rr = r & 15, cc = c & 31, ob = rr * 64 + cc * 2; return st * 1024 + (ob ^ (((ob >> 9) & 1) << 5)); }
__host__ __device__ __forceinline__ void stage_rc(int b, int& R, int& C) { const int st = b / 1024, sb = b % 1024, swz = sb ^ (((sb >> 9) & 1) << 5); R = (st >> 1) * 16 + swz / 64; C = (st & 1) * 32 + (swz % 64) / 2; }
__host__ __device__ __forceinline__ int perm32(int rho) { const int n = rho >> 4, i = rho & 15; return 8 * (i >> 2) + 4 * n + (i & 3); }

struct Unit { int pm, pn, kofs; };
struct Gemm { const bf16_t* A; const bf16_t* Bt; int lda, K; };

struct StaticOrder {
    int nM, nN, nwg, G, c;
    __device__ void init(int M, int N, int G_, int c_) { nM = M / BM; nN = N / BM; nwg = nM * nN; G = G_; c = c_; }
    __device__ bool next(int i, Unit& u) const {
        const long L = (long)i * G + c; if (L >= nwg) return false;
        int wgid = (int)L; { const int q = nwg / NXCD, r = nwg % NXCD, xcd = wgid % NXCD, off = wgid / NXCD; wgid = (xcd < r ? xcd * (q + 1) : r * (q + 1) + (xcd - r) * q) + off; }
        const int nig = WGM * nN, gid = wgid / nig, fm = gid * WGM, gsz = (nM - fm) < WGM ? (nM - fm) : WGM;
        u.pm = fm + ((wgid % nig) % gsz); u.pn = (wgid % nig) / gsz; u.kofs = 0; return true;
    }
};
struct GateOrder {
    int G, c;
    __device__ bool next(int i, Unit& u) const {
        const int L = i * G + c; if (L >= 512) return false;
        u.pm = L & 31; u.pn = L >> 5; u.kofs = (u.pn >> 1) * 256; return true;
    }
};

template <class Epi, class Sched>
__device__ __forceinline__ void gemm_phase(const int wid_s, LAS unsigned char* lds, const Gemm g, const Sched& S, const Epi& E) {
    const int lane = lane_fresh(), wid = wid_s, tid = wid * 64 + lane; const int wr = wid >> 2, wc = wid & 3, fr = lane & 15, fq = lane >> 4;
    const int K = g.K, lda = g.lda, nt = K / BK;
    unsigned voffA[2], voffB[2];
#pragma unroll
    for (int i = 0; i < 2; ++i) { int R, C; stage_rc(tid * 16 + i * 8192, R, C); const int Rb = (R & ~31) + perm32(R & 31);
        voffA[i] = (unsigned)(R * lda + C) * 2u; voffB[i] = (unsigned)(Rb * K + C) * 2u; }
    const size_t kstep = (size_t)(BK * 2);
    const size_t hstepA = (size_t)HALF * lda * 2, hstepB = (size_t)HALF * K * 2;
    const size_t tstepA = 2 * hstepA, tstepB = 2 * hstepB;
    const unsigned ldsw = (unsigned)wid * 1024u;
    const int aoff = lds_byte(wr * 64 + fr, fq * 8), boff = lds_byte(wc * 32 + fr, fq * 8);
#define PG8_SA(b, h) (((b) * 2 + (h)) * HTB)
#define PG8_SB(b, h) ((4 + (b) * 2 + (h)) * HTB)
#define PG8_STAGE(bufoff, gbase, voff) do { _Pragma("unroll") for (int _i = 0; _i < 2; ++_i) \
        __builtin_amdgcn_global_load_lds((const unsigned*)((const char*)(gbase) + (voff)[_i]), (LAS unsigned*)(lds + (bufoff) + ldsw + _i * 8192), 16, 0, 0); } while (0)
#define PG8_LDA(dst, b, h) do { _Pragma("unroll") for (int m = 0; m < 4; ++m) _Pragma("unroll") for (int k = 0; k < 2; ++k) dst[m][k] = *(const LAS bf16x8*)(lds + PG8_SA(b, h) + aoff + m * 2048 + k * 1024); } while (0)
#define PG8_LDB(dst, b, h) do { _Pragma("unroll") for (int n = 0; n < 2; ++n) _Pragma("unroll") for (int k = 0; k < 2; ++k) dst[n][k] = *(const LAS bf16x8*)(lds + PG8_SB(b, h) + boff + n * 2048 + k * 1024); } while (0)
#define PG8_MMA(ai, bj, At, Bt) do { __builtin_amdgcn_s_setprio(1); _Pragma("unroll") for (int m = 0; m < 4; ++m) _Pragma("unroll") for (int n = 0; n < 2; ++n) _Pragma("unroll") for (int k = 0; k < 2; ++k) \
        acc[ai][bj][m][n] = __builtin_amdgcn_mfma_f32_16x16x32_bf16(Bt[n][k], At[m][k], acc[ai][bj][m][n], 0, 0, 0); __builtin_amdgcn_s_setprio(0); } while (0)
#define PG8_WAIT_V(n) asm volatile("s_waitcnt vmcnt(" #n ")" ::: "memory")
#define PG8_WAIT_L(n) asm volatile("s_waitcnt lgkmcnt(" #n ")" ::: "memory")
#define PG8_BAR __builtin_amdgcn_s_barrier()
#define PG8_SCHED __builtin_amdgcn_sched_barrier(0)
    Unit cur, nxt; int ui = 0;
    if (!S.next(0, cur)) return;
    f32x4 acc[2][2][4][2];
#pragma unroll
    for (int a = 0; a < 2; ++a)
#pragma unroll
        for (int b = 0; b < 2; ++b)
#pragma unroll
            for (int m = 0; m < 4; ++m)
#pragma unroll
                for (int n = 0; n < 2; ++n) acc[a][b][m][n] = (f32x4){0.f, 0.f, 0.f, 0.f};
    bf16x8 At[4][2], B0[2][2], B1[2][2];
    const char* cA = (const char*)g.A + (size_t)cur.pm * tstepA + (size_t)cur.kofs * 2; const char* cB = (const char*)g.Bt + (size_t)cur.pn * tstepB;
    {
        PG8_STAGE(PG8_SB(0, 0), cB, voffB); PG8_STAGE(PG8_SB(0, 1), cB + hstepB, voffB); PG8_STAGE(PG8_SA(0, 0), cA, voffA); PG8_STAGE(PG8_SA(0, 1), cA + hstepA, voffA);
        if (wr == 1) PG8_BAR;
        PG8_WAIT_V(2); PG8_BAR;
        PG8_STAGE(PG8_SB(1, 0), cB + kstep, voffB); PG8_STAGE(PG8_SA(1, 0), cA + kstep, voffA); PG8_STAGE(PG8_SB(1, 1), cB + hstepB + kstep, voffB);
        PG8_WAIT_V(6); PG8_BAR;
    }
    for (;;) {
        const bool has_next = S.next(ui + 1, nxt);
        const char* nA = has_next ? (const char*)g.A + (size_t)nxt.pm * tstepA + (size_t)nxt.kofs * 2 : cA; const char* nB = has_next ? (const char*)g.Bt + (size_t)nxt.pn * tstepB : cB;
        for (int t = 0; t < nt; t += 2) {
            const bool last = (t == nt - 2);
            const char* a1 = cA + (size_t)(t + 1) * kstep;
            const char* a2 = last ? nA : cA + (size_t)(t + 2) * kstep; const char* b2 = last ? nB : cB + (size_t)(t + 2) * kstep;
            const char* a3 = a2 + kstep; const char* b3 = b2 + kstep;
            PG8_LDB(B0, 0, 0); PG8_LDB(B1, 0, 1); PG8_SCHED; PG8_LDA(At, 0, 0); PG8_STAGE(PG8_SA(1, 1), a1 + hstepA, voffA);
            PG8_WAIT_V(8); PG8_WAIT_L(0); PG8_BAR; PG8_MMA(0, 0, At, B0); PG8_MMA(0, 1, At, B1); PG8_BAR; PG8_SCHED;
            PG8_LDA(At, 0, 1); PG8_STAGE(PG8_SB(0, 0), b2, voffB); PG8_STAGE(PG8_SB(0, 1), b2 + hstepB, voffB); PG8_STAGE(PG8_SA(0, 0), a2, voffA);
            PG8_WAIT_V(8); PG8_WAIT_L(0); PG8_BAR; PG8_MMA(1, 0, At, B0); PG8_MMA(1, 1, At, B1); PG8_BAR; PG8_SCHED;
            PG8_LDB(B0, 1, 0); PG8_LDB(B1, 1, 1); PG8_SCHED; PG8_LDA(At, 1, 0); PG8_STAGE(PG8_SA(0, 1), a2 + hstepA, voffA);
            PG8_WAIT_V(8); PG8_WAIT_L(0); PG8_BAR; PG8_MMA(0, 0, At, B0); PG8_MMA(0, 1, At, B1); PG8_BAR; PG8_SCHED;
            PG8_LDA(At, 1, 1); PG8_STAGE(PG8_SB(1, 0), b3, voffB); PG8_STAGE(PG8_SB(1, 1), b3 + hstepB, voffB); PG8_STAGE(PG8_SA(1, 0), a3, voffA);
            PG8_WAIT_V(8); PG8_WAIT_L(0); PG8_BAR; PG8_MMA(1, 0, At, B0); PG8_MMA(1, 1, At, B1); PG8_BAR; PG8_SCHED;
        }
        if (wr == 0) PG8_BAR;
        { const int l2 = lane_fresh(); E(acc, cur, wr, wc, l2 & 15, l2 >> 4); }
        if (!has_next) break;
#pragma unroll
        for (int a = 0; a < 2; ++a)
#pragma unroll
            for (int b = 0; b < 2; ++b)
#pragma unroll
                for (int m = 0; m < 4; ++m)
#pragma unroll
                    for (int n = 0; n < 2; ++n) acc[a][b][m][n] = (f32x4){0.f, 0.f, 0.f, 0.f};
        cur = nxt; cA = nA; cB = nB; ++ui;
        if (wr == 1) PG8_BAR;
    }
    PG8_WAIT_V(0);
    PG8_BAR;
#undef PG8_SA
#undef PG8_SB
#undef PG8_STAGE
#undef PG8_LDA
#undef PG8_LDB
#undef PG8_MMA
#undef PG8_WAIT_V
#undef PG8_WAIT_L
#undef PG8_BAR
#undef PG8_SCHED
}

__device__ __forceinline__ void store8_bf16(bf16_t* p, f32x4 v0, f32x4 v1) {
    u32x4 w; w.x = cvt_pk_bf16(v0[0], v0[1]); w.y = cvt_pk_bf16(v0[2], v0[3]); w.z = cvt_pk_bf16(v1[0], v1[1]); w.w = cvt_pk_bf16(v1[2], v1[3]);
    *(u32x4*)p = w;
}
__device__ __forceinline__ f32x4 silu4(f32x4 v, float s) { f32x4 r; r[0] = siluf_(v[0]) * s; r[1] = siluf_(v[1]) * s; r[2] = siluf_(v[2]) * s; r[3] = siluf_(v[3]) * s; return r; }
__device__ __forceinline__ float logf_gate(float v, float lb) {
    const float ls = fminf(v, 0.f) - __logf(1.f + __expf(-fabsf(v)));
    return lb > 0.f ? __logf(lb + (1.f - lb) * __expf(ls)) : ls;
}

struct EpiRecIn {
    bf16_t* proj; float* logfb; const float* lb; const float* ssq;
    __device__ __forceinline__ void operator()(const f32x4 (&acc)[2][2][4][2], const Unit& u, int wr, int wc, int fr, int fq) const {
        const int row0 = u.pm * BM + wr * 64 + fr, colt = u.pn * BM, seg = colt >> 11, col0 = colt + wc * 32 + 8 * fq;
#pragma unroll
        for (int ai = 0; ai < 2; ++ai)
#pragma unroll
            for (int m = 0; m < 4; ++m) {
                const size_t row = (size_t)(row0 + ai * HALF + m * 16);
                const float rs = ssq ? rsqrtf(ssq[row] * (1.f / 2048.f) + 1e-6f) : 1.f;
#pragma unroll
                for (int bj = 0; bj < 2; ++bj) {
                    const int c = col0 + bj * HALF;
                    f32x4 v0 = acc[ai][bj][m][0] * rs, v1 = acc[ai][bj][m][1] * rs;
                    if (seg == 3) {
                        const int cc = c - 6144;
                        const f32x4 l0 = *(const f32x4*)(lb + cc), l1 = *(const f32x4*)(lb + cc + 4);
                        f32x4 o0, o1;
                        f32x4 k0, k1;
#pragma unroll
                        for (int e = 0; e < 4; ++e) { o0[e] = logf_gate(v0[e], l0[e]) * 1.4426950408889634f; o1[e] = logf_gate(v1[e], l1[e]) * 1.4426950408889634f;     k0[e] = (1.f - l0[e]) * sigmoidf_(-v0[e]); k1[e] = (1.f - l1[e]) * sigmoidf_(-v1[e]); }
                        *(f32x4*)(logfb + row * 2048 + cc) = o0; *(f32x4*)(logfb + row * 2048 + cc + 4) = o1;
                        store8_bf16(proj + row * REC_IN + c, k0, k1);
                    } else {
                        if (seg == 1 || seg == 5) { v0 = silu4(v0, 1.f); v1 = silu4(v1, 1.f); }
                        else if (seg == 2) { v0 = silu4(v0, 0.08838834764831845f); v1 = silu4(v1, 0.08838834764831845f); }
                        store8_bf16(proj + row * REC_IN + c, v0, v1);
                    }
                }
            }
    }
};
struct EpiAttIn {
    bf16_t* proj; const float* ssq; const float* qn; const float* kn; const float* ropetab; bf16_t* vT; LAS unsigned char* xlds;
    __device__ __forceinline__ void operator()(const f32x4 (&acc)[2][2][4][2], const Unit& u, int wr, int wc, int fr, int fq) const {
        const int row0 = u.pm * BM + wr * 64 + fr, colt = u.pn * BM, seg = colt >> 11, col0 = colt + wc * 32 + 8 * fq;
        if (seg < 2) {
            LAS float* xs = (LAS float*)xlds;
            float rsv[2][4];
#pragma unroll
            for (int ai = 0; ai < 2; ++ai)
#pragma unroll
                for (int m = 0; m < 4; ++m) {
                    const int rl = wr * 64 + ai * HALF + m * 16 + fr;
                    const float rs = rsqrtf(ssq[(size_t)(u.pm * BM + rl)] * (1.f / 2048.f) + 1e-6f);
                    rsv[ai][m] = rs;
#pragma unroll
                    for (int bj = 0; bj < 2; ++bj) {
                        const f32x4 a0 = acc[ai][bj][m][0] * rs, a1 = acc[ai][bj][m][1] * rs;
                        float ps = a0[0] * a0[0] + a0[1] * a0[1] + a0[2] * a0[2] + a0[3] * a0[3] + a1[0] * a1[0] + a1[1] * a1[1] + a1[2] * a1[2] + a1[3] * a1[3];
                        ps += __shfl_xor(ps, 16); ps += __shfl_xor(ps, 32);
                        if (fq == 0) xs[(rl * 2 + bj) * 4 + wc] = ps;
                    }
                }
            asm volatile("s_waitcnt lgkmcnt(0)" ::: "memory");
            __builtin_amdgcn_s_barrier();
            asm volatile("" ::: "memory");
            const float* gw = (seg == 0 ? qn : kn) + wc * 32 + 8 * fq;
            const f32x4 g0 = *(const f32x4*)gw, g1 = *(const f32x4*)(gw + 4);
            const float qs = seg == 0 ? 0.12751743f : 1.f;
#pragma unroll
            for (int ai = 0; ai < 2; ++ai)
#pragma unroll
                for (int m = 0; m < 4; ++m) {
                    const int rl = wr * 64 + ai * HALF + m * 16 + fr;
                    const size_t row = (size_t)(u.pm * BM + rl);
                    f32x4 c0 = (f32x4){1.f, 1.f, 1.f, 1.f}, c1 = c0, s0 = (f32x4){0.f, 0.f, 0.f, 0.f}, s1 = s0;
                    if (wc == 0) {
                        const float* rp = ropetab + (size_t)(row & (S_ - 1)) * 32 + (fq & 1) * 8;
                        c0 = *(const f32x4*)rp; c1 = *(const f32x4*)(rp + 4); s0 = *(const f32x4*)(rp + 16); s1 = *(const f32x4*)(rp + 20);
                        if (fq < 2) { s0 = -s0; s1 = -s1; }
                    }
#pragma unroll
                    for (int bj = 0; bj < 2; ++bj) {
                        const f32x4 pv = *(const LAS f32x4*)(xs + (rl * 2 + bj) * 4);
                        const float rstd = rsqrtf((pv[0] + pv[1] + pv[2] + pv[3]) * (1.f / 128.f) + 1e-6f) * qs;
                        f32x4 v0 = acc[ai][bj][m][0] * rsv[ai][m] * g0, v1 = acc[ai][bj][m][1] * rsv[ai][m] * g1;
                        if (wc == 0) {
                            f32x4 o0, o1;
#pragma unroll
                            for (int e = 0; e < 4; ++e) { o0[e] = __shfl_xor(v0[e], 32); o1[e] = __shfl_xor(v1[e], 32); }
                            v0 = v0 * c0 + o0 * s0; v1 = v1 * c1 + o1 * s1;
                        }
                        store8_bf16(proj + row * ATT_IN + col0 + bj * HALF, v0 * rstd, v1 * rstd);
                    }
                }
        } else if (seg == 2) {
#pragma unroll
            for (int ai = 0; ai < 2; ++ai)
#pragma unroll
                for (int m = 0; m < 4; ++m) {
                    const int row = row0 + ai * HALF + m * 16;
                    const float rs = rsqrtf(ssq[row] * (1.f / 2048.f) + 1e-6f);
                    const int bb = row >> 11, sp = row & (S_ - 1);
#pragma unroll
                    for (int bj = 0; bj < 2; ++bj) {
                        const int c = col0 + bj * HALF - 4096;
                        bf16_t* dst = vT + ((size_t)(bb * 8) * 256 + c) * S_ + sp;
                        const f32x4 a0 = acc[ai][bj][m][0] * rs, a1 = acc[ai][bj][m][1] * rs;
                        const unsigned w0 = cvt_pk_bf16(a0[0], a0[1]), w1 = cvt_pk_bf16(a0[2], a0[3]), w2 = cvt_pk_bf16(a1[0], a1[1]), w3 = cvt_pk_bf16(a1[2], a1[3]);
                        dst[0] = (bf16_t)(w0 & 0xffffu); dst[S_] = (bf16_t)(w0 >> 16); dst[2 * S_] = (bf16_t)(w1 & 0xffffu); dst[3 * S_] = (bf16_t)(w1 >> 16);
                        dst[4 * S_] = (bf16_t)(w2 & 0xffffu); dst[5 * S_] = (bf16_t)(w2 >> 16); dst[6 * S_] = (bf16_t)(w3 & 0xffffu); dst[7 * S_] = (bf16_t)(w3 >> 16);
                    }
                }
        } else {
#pragma unroll
            for (int ai = 0; ai < 2; ++ai)
#pragma unroll
                for (int m = 0; m < 4; ++m) {
                    const size_t row = (size_t)(row0 + ai * HALF + m * 16);
                    const float rs = rsqrtf(ssq[row] * (1.f / 2048.f) + 1e-6f);
#pragma unroll
                    for (int bj = 0; bj < 2; ++bj)
                        store8_bf16(proj + row * ATT_IN + col0 + bj * HALF, silu4(acc[ai][bj][m][0] * rs, 1.f), silu4(acc[ai][bj][m][1] * rs, 1.f));
                }
        }
    }
};
struct EpiResid {
    const float* xin; float* xout; const float* gnext; bf16_t* hnext; float* ssq;
    __device__ __forceinline__ void operator()(const f32x4 (&acc)[2][2][4][2], const Unit& u, int wr, int wc, int fr, int fq) const {
        const int row0 = u.pm * BM + wr * 64 + fr, col0 = u.pn * BM + wc * 32 + 8 * fq;
        const bool nx = gnext != nullptr;
#pragma unroll
        for (int ai = 0; ai < 2; ++ai)
#pragma unroll
            for (int m = 0; m < 4; ++m) {
                const size_t row = (size_t)(row0 + ai * HALF + m * 16);
                float ps = 0.f;
#pragma unroll
                for (int bj = 0; bj < 2; ++bj) {
                    const size_t idx = row * 2048 + col0 + bj * HALF;
                    const f32x4 x0 = *(const f32x4*)(xin + idx) + acc[ai][bj][m][0], x1 = *(const f32x4*)(xin + idx + 4) + acc[ai][bj][m][1];
                    *(f32x4*)(xout + idx) = x0; *(f32x4*)(xout + idx + 4) = x1;
                    if (nx) {
                        const f32x4 g0 = *(const f32x4*)(gnext + col0 + bj * HALF), g1 = *(const f32x4*)(gnext + col0 + bj * HALF + 4);
                        store8_bf16(hnext + idx, x0 * g0, x1 * g1);
                        ps += x0[0] * x0[0] + x0[1] * x0[1] + x0[2] * x0[2] + x0[3] * x0[3] + x1[0] * x1[0] + x1[1] * x1[1] + x1[2] * x1[2] + x1[3] * x1[3];
                    }
                }
                if (nx) {
                    ps += __shfl_xor(ps, 16); ps += __shfl_xor(ps, 32);
                    if (fq == 0) (void)__hip_atomic_fetch_add(ssq + row, ps, __ATOMIC_RELAXED, __HIP_MEMORY_SCOPE_AGENT);
                }
            }
    }
};
struct EpiGate {
    const bf16_t* xc; const float* ba; const float* bx; const float* lam; bf16_t* a_out; bf16_t* u_out;
    __device__ __forceinline__ void operator()(const f32x4 (&acc)[2][2][4][2], const Unit& u, int wr, int wc, int fr, int fq) const {
        const int row0 = u.pm * BM + wr * 64 + fr;
        const int c0 = (u.pn >> 1) * 256 + (u.pn & 1) * 128 + wc * 32 + 8 * fq;
        float bav[8], bxv[8], spv[8];
#pragma unroll
        for (int e = 0; e < 8; ++e) { bav[e] = ba[c0 + e]; bxv[e] = bx[c0 + e]; const float l = lam[c0 + e]; spv[e] = -8.f * (fmaxf(-l, 0.f) + __logf(1.f + __expf(-fabsf(l)))); }
#pragma unroll
        for (int ai = 0; ai < 2; ++ai)
#pragma unroll
            for (int m = 0; m < 4; ++m) {
                const size_t idx = (size_t)(row0 + ai * HALF + m * 16) * 2048 + c0;
                const u32x4 xw = *(const u32x4*)(xc + idx);
                float xv[8] = {bflo(xw.x), bfhi(xw.x), bflo(xw.y), bfhi(xw.y), bflo(xw.z), bfhi(xw.z), bflo(xw.w), bfhi(xw.w)};
                f32x4 ao[2], uo[2];
#pragma unroll
                for (int n = 0; n < 2; ++n)
#pragma unroll
                    for (int e = 0; e < 4; ++e) {
                        const int q = n * 4 + e;
                        const float r = sigmoidf_(acc[ai][0][m][n][e] + bav[q]), ig = sigmoidf_(acc[ai][1][m][n][e] + bxv[q]);
                        const float log_a = r * spv[q];
                        ao[n][e] = log_a;
                        uo[n][e] = __builtin_amdgcn_sqrtf(neg_expm1(2.f * log_a)) * (ig * xv[q]);
                    }
                store8_bf16(a_out + idx, ao[0], ao[1]);
                store8_bf16(u_out + idx, uo[0], uo[1]);
            }
    }
};
}

__device__ void transpose_w(const int wid_s, const int vb, const int nb, const float* __restrict__ W, bf16_t* __restrict__ Wt, int K, int N, float* sm, const int rs_hi = 128, const int rs_off = 0) {
    const int tidx = tid_opaque();
    const int tid = tidx, tn = N / 128, ntile = (K / 64) * tn;
    for (int tile = vb; tile < ntile; tile += nb) {
        const int k0 = (tile / tn) * 64, n0 = (tile % tn) * 128;
        f32x4 v[4];
#pragma unroll
        for (int i = 0; i < 4; ++i) v[i] = *(const f32x4*)(W + (size_t)(k0 + (tid >> 5) + 16 * i) * N + n0 + (tid & 31) * 4);
#pragma unroll
        for (int i = 0; i < 4; ++i) {
            float* d = sm + ((tid >> 5) + 16 * i) * 129 + (tid & 31) * 4;
            d[0] = v[i][0]; d[1] = v[i][1]; d[2] = v[i][2]; d[3] = v[i][3];
        }
        __syncthreads();
        {
            const int n = tid >> 2, kc = (tid & 3) * 16;
            u32x4 w0, w1;
            w0.x = cvt_pk_bf16(sm[(kc + 0) * 129 + n], sm[(kc + 1) * 129 + n]); w0.y = cvt_pk_bf16(sm[(kc + 2) * 129 + n], sm[(kc + 3) * 129 + n]);
            w0.z = cvt_pk_bf16(sm[(kc + 4) * 129 + n], sm[(kc + 5) * 129 + n]); w0.w = cvt_pk_bf16(sm[(kc + 6) * 129 + n], sm[(kc + 7) * 129 + n]);
            w1.x = cvt_pk_bf16(sm[(kc + 8) * 129 + n], sm[(kc + 9) * 129 + n]); w1.y = cvt_pk_bf16(sm[(kc + 10) * 129 + n], sm[(kc + 11) * 129 + n]);
            w1.z = cvt_pk_bf16(sm[(kc + 12) * 129 + n], sm[(kc + 13) * 129 + n]); w1.w = cvt_pk_bf16(sm[(kc + 14) * 129 + n], sm[(kc + 15) * 129 + n]);
            const int nn = n0 + n;
            bf16_t* dp = Wt + (size_t)((nn >> 7) * rs_hi + (nn & 127) + rs_off) * K + k0 + kc;
            *(u32x4*)dp = w0; *(u32x4*)(dp + 8) = w1;
        }
        __syncthreads();
    }
}

__device__ void rmsnorm_phase(const int wid_s, const float* __restrict__ x, const float* __restrict__ g, bf16_t* __restrict__ out) {
    const int tidx = tid_opaque();
    const int lane = tidx & 63, wv = blockIdx.x * 8 + (tidx >> 6), nw = gridDim.x * 8;
    for (int row = wv; row < T_; row += nw) {
        const float* xr = x + (size_t)row * 2048;
        f32x4 v[8]; float ss = 0.f;
#pragma unroll
        for (int i = 0; i < 8; ++i) { v[i] = *(const f32x4*)(xr + i * 256 + lane * 4); ss += v[i][0] * v[i][0] + v[i][1] * v[i][1] + v[i][2] * v[i][2] + v[i][3] * v[i][3]; }
        ss = wave_sum(ss);
        const float r = rsqrtf(ss * (1.f / 2048.f) + 1e-6f);
#pragma unroll
        for (int i = 0; i < 8; ++i) {
            const f32x4 gg = *(const f32x4*)(g + i * 256 + lane * 4);
            u32x2 w; w.x = cvt_pk_bf16(v[i][0] * r * gg[0], v[i][1] * r * gg[1]); w.y = cvt_pk_bf16(v[i][2] * r * gg[2], v[i][3] * r * gg[3]);
            *(u32x2*)(out + (size_t)row * 2048 + i * 256 + lane * 4) = w;
        }
    }
}

__device__ void conv_phase(const int wid_s, const int vb, const int nb, const bf16_t* __restrict__ proj, const float* __restrict__ w, const float* __restrict__ b, bf16_t* __restrict__ xc) {
    const int tidx = tid_opaque();
    const int gt = vb * NTHR + tidx, ng = nb * NTHR;
    for (int it = gt; it < T_ * 256; it += ng) {
        const int t = it >> 8, c = (it & 255) * 8, s = t & (S_ - 1);
        float y[8];
#pragma unroll
        for (int e = 0; e < 8; ++e) y[e] = b[c + e];
#pragma unroll
        for (int tap = 0; tap < 4; ++tap) {
            if (s - 3 + tap >= 0) {
                const u32x4 xw = *(const u32x4*)(proj + (size_t)(t - 3 + tap) * REC_IN + c);
                const float* wp = w + tap * 2048 + c;
                y[0] += bflo(xw.x) * wp[0]; y[1] += bfhi(xw.x) * wp[1]; y[2] += bflo(xw.y) * wp[2]; y[3] += bfhi(xw.y) * wp[3];
                y[4] += bflo(xw.z) * wp[4]; y[5] += bfhi(xw.z) * wp[5]; y[6] += bflo(xw.w) * wp[6]; y[7] += bfhi(xw.w) * wp[7];
            }
        }
        u32x4 o; o.x = cvt_pk_bf16(y[0], y[1]); o.y = cvt_pk_bf16(y[2], y[3]); o.z = cvt_pk_bf16(y[4], y[5]); o.w = cvt_pk_bf16(y[6], y[7]);
        *(u32x4*)(xc + (size_t)t * 2048 + c) = o;
    }
}

__device__ void scan_a_phase(const int wid_s, const int vb, const int nb, const bf16_t* __restrict__ la, const bf16_t* __restrict__ u, float* __restrict__ sumP, float* __restrict__ sumH) {
    const int tidx = tid_opaque();
    const int gt = vb * NTHR + tidx, ng = nb * NTHR;
    for (int it = gt; it < NB_ * 32 * 512; it += ng) {
        const int c4 = it & 511, ch = (it >> 9) & 31, b = it >> 14;
        const size_t base = ((size_t)(b * S_ + ch * 64)) * 2048 + c4 * 4;
        float sl[4] = {0.f, 0.f, 0.f, 0.f}, h[4] = {0.f, 0.f, 0.f, 0.f};
        for (int s0 = 0; s0 < 64; s0 += 16) {
            u32x2 aw[16], uw[16];
#pragma unroll
            for (int s = 0; s < 16; ++s) { aw[s] = *(const u32x2*)(la + base + (size_t)(s0 + s) * 2048); uw[s] = *(const u32x2*)(u + base + (size_t)(s0 + s) * 2048); }
            __builtin_amdgcn_sched_barrier(0);
#pragma unroll
            for (int s = 0; s < 16; ++s) {
                const float l[4] = {bflo(aw[s].x), bfhi(aw[s].x), bflo(aw[s].y), bfhi(aw[s].y)}, uu[4] = {bflo(uw[s].x), bfhi(uw[s].x), bflo(uw[s].y), bfhi(uw[s].y)};
#pragma unroll
                for (int e = 0; e < 4; ++e) { sl[e] += l[e]; h[e] = __expf(l[e]) * h[e] + uu[e]; }
            }
        }
        const size_t si = ((size_t)(b * 32 + ch)) * 2048 + c4 * 4;
        *(f32x4*)(sumP + si) = (f32x4){__expf(sl[0]), __expf(sl[1]), __expf(sl[2]), __expf(sl[3])}; *(f32x4*)(sumH + si) = (f32x4){h[0], h[1], h[2], h[3]};
    }
}
__device__ void scan_b_phase(const int wid_s, const int vb, const int nb, const bf16_t* __restrict__ la, const bf16_t* __restrict__ u, const float* __restrict__ sumP, const float* __restrict__ sumH,
                             const bf16_t* __restrict__ proj, bf16_t* __restrict__ y) {
    const int tidx = tid_opaque();
    const int gt = vb * NTHR + tidx, ng = nb * NTHR;
    for (int it = gt; it < NB_ * 32 * 512; it += ng) {
        const int c4 = it & 511, ch = (it >> 9) & 31, b = it >> 14;
        const size_t t0 = (size_t)(b * S_ + ch * 64);
        u32x2 aw[16], uw[16], gw[16];
#pragma unroll
        for (int s = 0; s < 16; ++s) { const size_t t = t0 + s; aw[s] = *(const u32x2*)(la + t * 2048 + c4 * 4); uw[s] = *(const u32x2*)(u + t * 2048 + c4 * 4); gw[s] = *(const u32x2*)(proj + t * REC_IN + 2048 + c4 * 4); }
        f32x4 h = (f32x4){0.f, 0.f, 0.f, 0.f};
        for (int j0 = 0; j0 < ch; j0 += 8) {
            f32x4 pv[8], hv[8];
#pragma unroll
            for (int j = 0; j < 8; ++j) { const int jj = (j0 + j < ch) ? j0 + j : ch - 1; const size_t si = ((size_t)(b * 32 + jj)) * 2048 + c4 * 4; pv[j] = *(const f32x4*)(sumP + si); hv[j] = *(const f32x4*)(sumH + si); }
            __builtin_amdgcn_sched_barrier(0);
#pragma unroll
            for (int j = 0; j < 8; ++j) if (j0 + j < ch) h = pv[j] * h + hv[j];
        }
        for (int s0 = 0; s0 < 64; s0 += 16) {
            __builtin_amdgcn_sched_barrier(0);
#pragma unroll
            for (int s = 0; s < 16; ++s) {
                const size_t t = t0 + s0 + s;
                h[0] = __expf(bflo(aw[s].x)) * h[0] + bflo(uw[s].x); h[1] = __expf(bfhi(aw[s].x)) * h[1] + bfhi(uw[s].x);
                h[2] = __expf(bflo(aw[s].y)) * h[2] + bflo(uw[s].y); h[3] = __expf(bfhi(aw[s].y)) * h[3] + bfhi(uw[s].y);
                *(u32x2*)(y + t * REC_OUT + c4 * 4) = (u32x2){cvt_pk_bf16(h[0] * bflo(gw[s].x), h[1] * bfhi(gw[s].x)), cvt_pk_bf16(h[2] * bflo(gw[s].y), h[3] * bfhi(gw[s].y))};
            }
            if (s0 + 16 < 64) {
#pragma unroll
                for (int s = 0; s < 16; ++s) { const size_t t = t0 + s0 + 16 + s; aw[s] = *(const u32x2*)(la + t * 2048 + c4 * 4); uw[s] = *(const u32x2*)(u + t * 2048 + c4 * 4); gw[s] = *(const u32x2*)(proj + t * REC_IN + 2048 + c4 * 4); }
            }
        }
    }
}
__device__ void att_qkv_phase(const int wid_s, bf16_t* __restrict__ proj, const float* __restrict__ qn, const float* __restrict__ kn, const float* __restrict__ ropetab, bf16_t* __restrict__ vT, bf16_t* sm) {
    const int tidx = tid_opaque();
    const int lane = tidx & 63, wv = blockIdx.x * 8 + (tidx >> 6), nw = gridDim.x * 8, j = lane & 15, gq = lane >> 4;
    float qw[8], kw8[8];
#pragma unroll
    for (int e = 0; e < 8; ++e) { qw[e] = qn[8 * j + e]; kw8[e] = kn[8 * j + e]; }
    for (int t = wv; t < T_; t += nw) {
        const int s = t & (S_ - 1);
        float cs[8], sn[8];
        {
            const float* rp = ropetab + s * 32 + (j & 1) * 8;
            const f32x4 c0 = *(const f32x4*)rp, c1 = *(const f32x4*)(rp + 4), s0 = *(const f32x4*)(rp + 16), s1 = *(const f32x4*)(rp + 20);
#pragma unroll
            for (int e = 0; e < 4; ++e) { cs[e] = c0[e]; cs[4 + e] = c1[e]; sn[e] = s0[e]; sn[4 + e] = s1[e]; }
        }
        bf16_t* row = proj + (size_t)t * ATT_IN + gq * 128 + 8 * j;
        u32x4 w[8];
#pragma unroll
        for (int c = 0; c < 8; ++c) w[c] = *(const u32x4*)(row + c * 512);
#pragma unroll
        for (int c = 0; c < 8; ++c) {
            float v[8] = {bflo(w[c].x), bfhi(w[c].x), bflo(w[c].y), bfhi(w[c].y), bflo(w[c].z), bfhi(w[c].z), bflo(w[c].w), bfhi(w[c].w)};
            float ss = 0.f;
#pragma unroll
            for (int e = 0; e < 8; ++e) ss += v[e] * v[e];
            ss += __shfl_xor(ss, 1); ss += __shfl_xor(ss, 2); ss += __shfl_xor(ss, 4); ss += __shfl_xor(ss, 8);
            const float r = rsqrtf(ss * (1.f / 128.f) + 1e-6f) * (c < 4 ? 0.12751743f : 1.f);
#pragma unroll
            for (int e = 0; e < 8; ++e) v[e] = v[e] * (c < 4 ? qw[e] : kw8[e]);
#pragma unroll
            for (int e = 0; e < 8; ++e) {
                const float o = __shfl_xor(v[e], 2);
                const float rot = j < 2 ? v[e] * cs[e] - o * sn[e] : v[e] * cs[e] + o * sn[e];
                v[e] = (j < 4 ? rot : v[e]) * r;
            }
            u32x4 o4; o4.x = cvt_pk_bf16(v[0], v[1]); o4.y = cvt_pk_bf16(v[2], v[3]); o4.z = cvt_pk_bf16(v[4], v[5]); o4.w = cvt_pk_bf16(v[6], v[7]);
            *(u32x4*)(row + c * 512) = o4;
        }
    }
    const int tid = tidx;
    for (int tile = blockIdx.x; tile < NB_ * 8 * 32 * 4; tile += gridDim.x) {
        const int vq = tile & 3, sb = (tile >> 2) & 31, hd = (tile >> 7) & 7, b = tile >> 10;
        {
            const int tok = tid >> 3, vc = (tid & 7) * 8;
            const u32x4 w = *(const u32x4*)(proj + ((size_t)(b * S_ + sb * 64 + tok)) * ATT_IN + 4096 + hd * 256 + vq * 64 + vc);
            *(u32x4*)(sm + tok * 72 + vc) = w;
        }
        __syncthreads();
        {
            const int vv = tid >> 3, tc = (tid & 7) * 8;
            unsigned short e[8];
#pragma unroll
            for (int i = 0; i < 8; ++i) e[i] = sm[(tc + i) * 72 + vv];
            u32x4 w; w.x = e[0] | ((unsigned)e[1] << 16); w.y = e[2] | ((unsigned)e[3] << 16); w.z = e[4] | ((unsigned)e[5] << 16); w.w = e[6] | ((unsigned)e[7] << 16);
            *(u32x4*)(vT + (((size_t)(b * 8 + hd)) * 256 + vq * 64 + vv) * S_ + sb * 64 + tc) = w;
        }
        __syncthreads();
    }
}

constexpr int HG_Q1 = 0, HG_Q2 = 17408, HG_K1 = 34816, HG_K2T = 52224, HG_VT = 70656, HG_P = 75264, HG_ST = 84480, HG_DEC = 93184, HG_TOT = 93696, HG_END = 97792;
static_assert(HG_END <= LDS_BYTES, "hgrn LDS");
__device__ __forceinline__ bf16x8 ldfrag(const LAS unsigned char* p) { return *(const LAS bf16x8*)p; }
__device__ __forceinline__ unsigned short bf1(float x) { return (unsigned short)(cvt_pk_bf16(x, 0.f) & 0xffffu); }


constexpr int HF_Q1 = 0, HF_Q2 = 17408, HF_K1 = 34816, HF_K2T = 52224, HF_VT = 70656, HF_P = 89088, HF_ST = 98304, HF_DEC = 133120, HF_TOT = 133632, HF_SSQ = 137728, HF_END = 138240;
static_assert(HF_END <= LDS_BYTES - 16, "hgrn full LDS");
template <int NVT>
__device__ void hgrn_full_phase(const int wid_s, const int item, const bf16_t* __restrict__ proj, const float* __restrict__ logfb, bf16_t* __restrict__ oraw,
                                const float* __restrict__ gon, bf16_t* __restrict__ y, LAS unsigned char* lds) {
    const int lane = lane_fresh(), tid = wid_s * 64 + lane, fr = lane & 15, fq = lane >> 4, w = wid_s;
    const int kp = lane, p8 = wid_s;
    const int b = NVT == 8 ? item >> 4 : item >> 5, hd = NVT == 8 ? item & 15 : (item >> 1) & 15, vs = NVT == 8 ? 0 : item & 1;
    constexpr int VW = 16 * NVT;
    for (int i = tid; i < (HF_DEC - HF_P) / 4; i += NTHR) ((LAS unsigned*)(lds + HF_P))[i] = 0u;
    f32x4 st[NVT];
#pragma unroll
    for (int n = 0; n < NVT; ++n) st[n] = (f32x4){0.f, 0.f, 0.f, 0.f};
    const float* lfp = logfb + ((size_t)(b * S_ + 8 * p8)) * 2048 + hd * 128 + 2 * kp;
    const bf16_t* qp = proj + ((size_t)(b * S_ + 8 * p8)) * REC_IN + 4096 + hd * 128 + 2 * kp;
    const bf16_t* vp = proj + ((size_t)(b * S_ + lane)) * REC_IN + 8192 + hd * 128 + vs * VW + w * (2 * NVT);
    f32x2 lfr[8]; unsigned qr[8], kr[8]; u32x4 vr0, vr1;
#pragma unroll
    for (int i = 0; i < 8; ++i) { lfr[i] = *(const f32x2*)(lfp + (size_t)i * 2048); qr[i] = *(const unsigned*)(qp + (size_t)i * REC_IN); kr[i] = *(const unsigned*)(qp + (size_t)i * REC_IN + 2048); }
    vr0 = *(const u32x4*)vp; vr1 = vr0; if (NVT == 8) vr1 = *(const u32x4*)(vp + 8);
    f32x4 ggh[NVT / 2];
#pragma unroll
    for (int q = 0; q < NVT / 2; ++q) ggh[q] = *(const f32x4*)(gon + 16 * ((w & 1) * (NVT / 2) + q) + 4 * fq);
    __syncthreads();
    for (int c = 0; c < 32; ++c) {
        f32x2 bl[8]; f32x2 cum = (f32x2){0.f, 0.f};
#pragma unroll
        for (int i = 0; i < 8; ++i) { cum += lfr[i]; bl[i] = cum; }
        *(LAS f32x2*)(lds + HF_TOT + (p8 * 128 + 2 * kp) * 4) = cum;
        __syncthreads();
        f32x2 off = (f32x2){0.f, 0.f}, bmid = (f32x2){0.f, 0.f}, blast = (f32x2){0.f, 0.f};
#pragma unroll
        for (int pp = 0; pp < 8; ++pp) {
            const f32x2 tv = *(const LAS f32x2*)(lds + HF_TOT + (pp * 128 + 2 * kp) * 4);
            if (pp < p8) off += tv;
            if (pp < 4) bmid += tv;
            blast += tv;
        }
        if (p8 == 0) *(LAS f32x2*)(lds + HF_DEC + 2 * kp * 4) = (f32x2){__builtin_amdgcn_exp2f(blast[0]), __builtin_amdgcn_exp2f(blast[1])};
        const f32x2 ek = (f32x2){__builtin_amdgcn_exp2f(blast[0] - bmid[0]), __builtin_amdgcn_exp2f(blast[1] - bmid[1])};
        float k2a[8], k2b[8];
#pragma unroll
        for (int i = 0; i < 8; ++i) {
            const int t = 8 * p8 + i;
            const f32x2 bq = off + bl[i];
            const float x0 = bq[0] - bmid[0], x1 = bq[1] - bmid[1];
            const float q0v = bflo(qr[i]), q1v = bfhi(qr[i]), k0v = bflo(kr[i]), k1v = bfhi(kr[i]);
            const float qa = q0v * __builtin_amdgcn_exp2f(fminf(x0, 115.f)), qb2 = q1v * __builtin_amdgcn_exp2f(fminf(x1, 115.f));
            const float ka = k0v * __builtin_amdgcn_exp2f(fminf(-x0, 115.f)), kb2 = k1v * __builtin_amdgcn_exp2f(fminf(-x1, 115.f));
            *(LAS unsigned*)(lds + HF_Q1 + t * 272 + kp * 4) = cvt_pk_bf16(qa, qb2);
            *(LAS unsigned*)(lds + HF_Q2 + t * 272 + kp * 4) = cvt_pk_bf16(q0v * __builtin_amdgcn_exp2f(bq[0]), q1v * __builtin_amdgcn_exp2f(bq[1]));
            *(LAS unsigned*)(lds + HF_K1 + t * 272 + kp * 4) = cvt_pk_bf16(ka, kb2);
            k2a[i] = ka * ek[0]; k2b[i] = kb2 * ek[1];
        }
        *(LAS u32x4*)(lds + HF_K2T + (2 * kp) * 144 + p8 * 16) = (u32x4){cvt_pk_bf16(k2a[0], k2a[1]), cvt_pk_bf16(k2a[2], k2a[3]), cvt_pk_bf16(k2a[4], k2a[5]), cvt_pk_bf16(k2a[6], k2a[7])};
        *(LAS u32x4*)(lds + HF_K2T + (2 * kp + 1) * 144 + p8 * 16) = (u32x4){cvt_pk_bf16(k2b[0], k2b[1]), cvt_pk_bf16(k2b[2], k2b[3]), cvt_pk_bf16(k2b[4], k2b[5]), cvt_pk_bf16(k2b[6], k2b[7])};
        {
            const int sv = lane, vv0 = w * (2 * NVT);
            const unsigned vw[8] = {vr0.x, vr0.y, vr0.z, vr0.w, vr1.x, vr1.y, vr1.z, vr1.w};
#pragma unroll
            for (int e = 0; e < NVT; ++e) {
                *(LAS unsigned short*)(lds + HF_VT + (vv0 + 2 * e) * 144 + sv * 2) = (unsigned short)(vw[e] & 0xffffu);
                *(LAS unsigned short*)(lds + HF_VT + (vv0 + 2 * e + 1) * 144 + sv * 2) = (unsigned short)(vw[e] >> 16);
            }
        }
        if (c + 1 < 32) {
            const size_t to = (size_t)(64 * (c + 1));
#pragma unroll
            for (int i = 0; i < 8; ++i) { lfr[i] = *(const f32x2*)(lfp + (to + i) * 2048); qr[i] = *(const unsigned*)(qp + (to + i) * REC_IN); kr[i] = *(const unsigned*)(qp + (to + i) * REC_IN + 2048); }
            vr0 = *(const u32x4*)(vp + to * REC_IN); if (NVT == 8) vr1 = *(const u32x4*)(vp + to * REC_IN + 8);
        }
        __syncthreads();
        for (int idx = w; idx < 10; idx += 8) {
            const int nt = idx >= 6 ? 3 : (idx >= 3 ? 2 : (idx >= 1 ? 1 : 0)), ms = idx - (nt * (nt + 1)) / 2;
            bf16x8 fa[4], fb[4];
#pragma unroll
            for (int ks = 0; ks < 4; ++ks) { fa[ks] = ldfrag(lds + HF_K1 + (16 * ms + fr) * 272 + 64 * ks + 16 * fq); fb[ks] = ldfrag(lds + HF_Q1 + (16 * nt + fr) * 272 + 64 * ks + 16 * fq); }
            __builtin_amdgcn_sched_barrier(0);
            f32x4 acc = (f32x4){0.f, 0.f, 0.f, 0.f}, acc2 = (f32x4){0.f, 0.f, 0.f, 0.f};
            acc = __builtin_amdgcn_mfma_f32_16x16x32_bf16(fa[0], fb[0], acc, 0, 0, 0);
            acc2 = __builtin_amdgcn_mfma_f32_16x16x32_bf16(fa[1], fb[1], acc2, 0, 0, 0);
            acc = __builtin_amdgcn_mfma_f32_16x16x32_bf16(fa[2], fb[2], acc, 0, 0, 0);
            acc2 = __builtin_amdgcn_mfma_f32_16x16x32_bf16(fa[3], fb[3], acc2, 0, 0, 0);
            acc += acc2;
            if (ms == nt) {
#pragma unroll
                for (int e = 0; e < 4; ++e) if (4 * fq + e > fr) acc[e] = 0.f;
            }
            *(LAS u32x2*)(lds + HF_P + (16 * nt + fr) * 144 + (16 * ms + 4 * fq) * 2) = (u32x2){cvt_pk_bf16_v(acc[0], acc[1]), cvt_pk_bf16_v(acc[2], acc[3])};
        }
        __syncthreads();
        f32x4 oacc[NVT / 2]; u32x2 gatew[NVT / 2];
        const int tt = w >> 1;
        {
            bf16x8 fb[6];
#pragma unroll
            for (int ks = 0; ks < 2; ++ks) fb[ks] = ldfrag(lds + HF_P + (16 * tt + fr) * 144 + 64 * ks + 16 * fq);
#pragma unroll
            for (int ks = 0; ks < 4; ++ks) fb[2 + ks] = ldfrag(lds + HF_Q2 + (16 * tt + fr) * 272 + 64 * ks + 16 * fq);
            if (NVT == 8) {
#pragma unroll
                for (int q = 0; q < NVT / 2; ++q)
                    gatew[q] = *(const u32x2*)(proj + ((size_t)(b * S_ + 64 * c + 16 * tt + fr)) * REC_IN + 10240 + hd * 128 + 16 * ((w & 1) * (NVT / 2) + q) + 4 * fq);
            }
#pragma unroll
            for (int q = 0; q < NVT / 2; ++q) {
                const int vt = (w & 1) * (NVT / 2) + q;
                bf16x8 fa[6];
#pragma unroll
                for (int ks = 0; ks < 2; ++ks) fa[ks] = ldfrag(lds + HF_VT + (16 * vt + fr) * 144 + 64 * ks + 16 * fq);
#pragma unroll
                for (int ks = 0; ks < 4; ++ks) fa[2 + ks] = ldfrag(lds + HF_ST + (16 * vt + fr) * 272 + 64 * ks + 16 * fq);
                __builtin_amdgcn_sched_barrier(0);
                f32x4 acc = (f32x4){0.f, 0.f, 0.f, 0.f}, acc2 = (f32x4){0.f, 0.f, 0.f, 0.f};
                acc = __builtin_amdgcn_mfma_f32_16x16x32_bf16(fa[0], fb[0], acc, 0, 0, 0);
                acc2 = __builtin_amdgcn_mfma_f32_16x16x32_bf16(fa[2], fb[2], acc2, 0, 0, 0);
                acc = __builtin_amdgcn_mfma_f32_16x16x32_bf16(fa[1], fb[1], acc, 0, 0, 0);
                acc2 = __builtin_amdgcn_mfma_f32_16x16x32_bf16(fa[3], fb[3], acc2, 0, 0, 0);
                acc = __builtin_amdgcn_mfma_f32_16x16x32_bf16(fa[4], fb[4], acc, 0, 0, 0);
                acc2 = __builtin_amdgcn_mfma_f32_16x16x32_bf16(fa[5], fb[5], acc2, 0, 0, 0);
                acc += acc2;
                if (NVT == 8) oacc[q] = acc;
                else *(u32x2*)(oraw + ((size_t)(b * S_ + 64 * c + 16 * tt + fr)) * 2048 + hd * 128 + vs * VW + 16 * vt + 4 * fq) = (u32x2){cvt_pk_bf16_v(acc[0], acc[1]), cvt_pk_bf16_v(acc[2], acc[3])};
            }
            if (NVT == 8) {
                float ps = 0.f;
#pragma unroll
                for (int q = 0; q < NVT / 2; ++q) ps += oacc[q][0] * oacc[q][0] + oacc[q][1] * oacc[q][1] + oacc[q][2] * oacc[q][2] + oacc[q][3] * oacc[q][3];
                ps += __shfl_xor(ps, 16); ps += __shfl_xor(ps, 32);
                if (fq == 0) ((LAS float*)(lds + HF_SSQ))[(w & 1) * 64 + 16 * tt + fr] = ps;
            }
            bf16x8 ka[2];
#pragma unroll
            for (int ks = 0; ks < 2; ++ks) ka[ks] = ldfrag(lds + HF_K2T + (16 * w + fr) * 144 + 64 * ks + 16 * fq);
            const f32x4 dv = *(const LAS f32x4*)(lds + HF_DEC + (16 * w + 4 * fq) * 4);
#pragma unroll
            for (int n = 0; n < NVT; n += 2) {
                bf16x8 vb2[4];
#pragma unroll
                for (int ks = 0; ks < 2; ++ks) { vb2[ks] = ldfrag(lds + HF_VT + (16 * n + fr) * 144 + 64 * ks + 16 * fq); vb2[2 + ks] = ldfrag(lds + HF_VT + (16 * n + 16 + fr) * 144 + 64 * ks + 16 * fq); }
                __builtin_amdgcn_sched_barrier(0);
                f32x4 s0 = st[n] * dv, s1 = st[n + 1] * dv;
                s0 = __builtin_amdgcn_mfma_f32_16x16x32_bf16(ka[0], vb2[0], s0, 0, 0, 0);
                s1 = __builtin_amdgcn_mfma_f32_16x16x32_bf16(ka[0], vb2[2], s1, 0, 0, 0);
                s0 = __builtin_amdgcn_mfma_f32_16x16x32_bf16(ka[1], vb2[1], s0, 0, 0, 0);
                s1 = __builtin_amdgcn_mfma_f32_16x16x32_bf16(ka[1], vb2[3], s1, 0, 0, 0);
                st[n] = s0; st[n + 1] = s1;
            }
        }
        __syncthreads();
        if (NVT == 8) {
            const float ssq = ((LAS float*)(lds + HF_SSQ))[16 * tt + fr] + ((LAS float*)(lds + HF_SSQ))[64 + 16 * tt + fr];
            const float rstd = rsqrtf(ssq * (1.f / 128.f) + 1e-6f);
#pragma unroll
            for (int q = 0; q < NVT / 2; ++q) {
                const int vv = 16 * ((w & 1) * (NVT / 2) + q) + 4 * fq;
                const f32x4 gg = ggh[q];
                const f32x4 o4 = oacc[q] * rstd * gg;
                *(u32x2*)(y + ((size_t)(b * S_ + 64 * c + 16 * tt + fr)) * REC_OUT + 2048 + hd * 128 + vv) =
                    (u32x2){cvt_pk_bf16_v(o4[0] * bflo(gatew[q].x), o4[1] * bfhi(gatew[q].x)), cvt_pk_bf16_v(o4[2] * bflo(gatew[q].y), o4[3] * bfhi(gatew[q].y))};
            }
        }
#pragma unroll
        for (int n = 0; n < NVT; ++n)
            *(LAS u32x2*)(lds + HF_ST + (16 * n + fr) * 272 + (16 * w + 4 * fq) * 2) = (u32x2){cvt_pk_bf16_v(st[n][0], st[n][1]), cvt_pk_bf16_v(st[n][2], st[n][3])};
    }
    __syncthreads();
}

__device__ __forceinline__ float xhalf_max(float x) { const auto r = __builtin_amdgcn_permlane32_swap(__float_as_uint(x), __float_as_uint(x), false, false); return fmaxf(__uint_as_float(r[0]), __uint_as_float(r[1])); }
__device__ __forceinline__ float xhalf_sum(float x) { const auto r = __builtin_amdgcn_permlane32_swap(__float_as_uint(x), __float_as_uint(x), false, false); return __uint_as_float(r[0]) + __uint_as_float(r[1]); }
typedef float f32x16 __attribute__((ext_vector_type(16)));
constexpr int AT_KROW = 272, AT_VROW = 72, AT_K2 = 32 * AT_KROW, AT_VT = 2 * AT_K2, AT_STAGE = AT_VT + 256 * AT_VROW;
constexpr int AT_Q = 2 * AT_STAGE;
static_assert(AT_Q + 8 * 32 * AT_KROW <= LDS_BYTES, "attention LDS");

__device__ void attn_phase(const int wid_s, const bf16_t* __restrict__ proj, const bf16_t* __restrict__ vT, const float* __restrict__ lamp, const float* __restrict__ gsub, const float mul,
                           bf16_t* __restrict__ y, LAS unsigned char* lds) {
    const int lane0 = lane_fresh(), rg = wid_s & 3, map = wid_s >> 2;
    const float lam = lamp[0];
    for (int pair = blockIdx.x; pair < 256; pair += gridDim.x) {
        const int pr = (gridDim.x == 256) ? ((pair & 7) * 32 + (pair >> 3)) : pair;
        const int qa = pr & 7, hd = (pr >> 3) & 7, b = pr >> 6;
        for (int half = 0; half < 2; ++half) {
            const int qb = half ? qa : 15 - qa;
            int lane = lane0; asm volatile("" : "+v"(lane));
            const int tid = wid_s * 64 + lane, r = lane & 31, h = lane >> 5;
            const int q0 = qb * 128 + rg * 32;
            const int nsteps = (qb + 1) * 4, mysteps = (q0 >> 5) + 1;
            const LAS unsigned char* qb_l = lds + AT_Q + wid_s * (32 * AT_KROW) + r * AT_KROW + 16 * h;
            {
                const int qr = lane >> 1, qc = (lane & 1) * 8;
                const bf16_t* qp = proj + ((size_t)(b * S_ + q0 + qr)) * ATT_IN + hd * 256 + map * 128 + qc * 8;
                LAS unsigned char* qw = lds + AT_Q + wid_s * (32 * AT_KROW) + qr * AT_KROW + qc * 16;
#pragma unroll
                for (int c = 0; c < 8; ++c) *(LAS u32x4*)(qw + c * 16) = *(const u32x4*)(qp + c * 8);
            }
            f32x16 o[8];
#pragma unroll
            for (int mt = 0; mt < 8; ++mt)
#pragma unroll
                for (int e = 0; e < 16; ++e) o[mt][e] = 0.f;
            float m = -INFINITY, l = 0.f;
            const bf16_t* kgb = proj + ((size_t)(b * S_)) * ATT_IN + 2048 + hd * 256;
            const bf16_t* vgb = vT + (((size_t)(b * 8 + hd)) * 256) * S_;
            const unsigned kgo = (unsigned)(tid >> 4) * ATT_IN + (tid & 15) * 8, vgo = (unsigned)(tid >> 2) * S_ + (tid & 3) * 8;
            const int kw = (tid >> 4) * AT_KROW + (tid & 15) * 16;
            const int vw = AT_VT + (tid >> 2) * AT_VROW + (tid & 3) * 16;
            u32x4 rk1, rk2, rv0, rv1;
            rk1 = *(const u32x4*)(kgb + kgo); rk2 = *(const u32x4*)(kgb + 128 + kgo); rv0 = *(const u32x4*)(vgb + vgo); rv1 = *(const u32x4*)(vgb + (size_t)128 * S_ + vgo);
            *(LAS u32x4*)(lds + kw) = rk1; *(LAS u32x4*)(lds + AT_K2 + kw) = rk2;
            *(LAS u32x2*)(lds + vw) = (u32x2){rv0.x, rv0.y}; *(LAS u32x2*)(lds + vw + 8) = (u32x2){rv0.z, rv0.w};
            *(LAS u32x2*)(lds + vw + 128 * AT_VROW) = (u32x2){rv1.x, rv1.y}; *(LAS u32x2*)(lds + vw + 128 * AT_VROW + 8) = (u32x2){rv1.z, rv1.w};
            __syncthreads();
            for (int i = 0; i < nsteps; ++i) {
                const int cur = (i & 1) * AT_STAGE, nxt = AT_STAGE - cur;
                const bool more = (i + 1 < nsteps);
                if (more) {
                    const bf16_t* kgi = kgb + (size_t)(32 * (i + 1)) * ATT_IN; const bf16_t* vgi = vgb + 32 * (i + 1);
                    rk1 = *(const u32x4*)(kgi + kgo); rk2 = *(const u32x4*)(kgi + 128 + kgo);
                    rv0 = *(const u32x4*)(vgi + vgo); rv1 = *(const u32x4*)(vgi + (size_t)128 * S_ + vgo);
                }
                if (i < mysteps) {
                    f32x16 st;
#pragma unroll
                    for (int e = 0; e < 16; ++e) st[e] = 0.f;
                    const LAS unsigned char* kb = lds + cur + map * AT_K2 + r * AT_KROW + 16 * h;
                    const LAS unsigned char* vb = lds + cur + AT_VT + r * AT_VROW + 8 * h;
                    {
                        bf16x8 kfa[4], qfa[4];
#pragma unroll
                        for (int e = 0; e < 4; ++e) { kfa[e] = *(const LAS bf16x8*)(kb + 32 * e); qfa[e] = *(const LAS bf16x8*)(qb_l + 32 * e); }
                        __builtin_amdgcn_sched_barrier(0);
                        f32x16 st2;
#pragma unroll
                        for (int e = 0; e < 16; ++e) st2[e] = 0.f;
                        st = __builtin_amdgcn_mfma_f32_32x32x16_bf16(kfa[0], qfa[0], st, 0, 0, 0);
                        st2 = __builtin_amdgcn_mfma_f32_32x32x16_bf16(kfa[1], qfa[1], st2, 0, 0, 0);
                        st = __builtin_amdgcn_mfma_f32_32x32x16_bf16(kfa[2], qfa[2], st, 0, 0, 0);
                        st2 = __builtin_amdgcn_mfma_f32_32x32x16_bf16(kfa[3], qfa[3], st2, 0, 0, 0);
#pragma unroll
                        for (int e = 0; e < 4; ++e) { kfa[e] = *(const LAS bf16x8*)(kb + 32 * (4 + e)); qfa[e] = *(const LAS bf16x8*)(qb_l + 32 * (4 + e)); }
                        __builtin_amdgcn_sched_barrier(0);
                        st = __builtin_amdgcn_mfma_f32_32x32x16_bf16(kfa[0], qfa[0], st, 0, 0, 0);
                        st2 = __builtin_amdgcn_mfma_f32_32x32x16_bf16(kfa[1], qfa[1], st2, 0, 0, 0);
                        st = __builtin_amdgcn_mfma_f32_32x32x16_bf16(kfa[2], qfa[2], st, 0, 0, 0);
                        st2 = __builtin_amdgcn_mfma_f32_32x32x16_bf16(kfa[3], qfa[3], st2, 0, 0, 0);
                        __builtin_amdgcn_sched_barrier(0);
#pragma unroll
                        for (int e = 0; e < 16; ++e) st[e] += st2[e];
                    }
                    u32x4 vfa[4];
#define AT_LDV(dst, mt, s2) do { const u32x2 _a0 = *(const LAS u32x2*)(vb + (mt) * 32 * AT_VROW + 32 * (s2)), _a1 = *(const LAS u32x2*)(vb + (mt) * 32 * AT_VROW + 32 * (s2) + 16); dst = (u32x4){_a0.x, _a0.y, _a1.x, _a1.y}; } while (0)
                    AT_LDV(vfa[0], 0, 0); AT_LDV(vfa[1], 1, 0); AT_LDV(vfa[2], 0, 1); AT_LDV(vfa[3], 1, 1);
                    __builtin_amdgcn_sched_barrier(0);
                    if (i == mysteps - 1) {
#pragma unroll
                        for (int e = 0; e < 16; ++e) { const int kk = (e & 3) + 8 * (e >> 2) + 4 * h; if (kk > r) st[e] = -INFINITY; }
                    }
                    float mloc = st[0];
#pragma unroll
                    for (int e = 1; e < 16; ++e) mloc = fmaxf(mloc, st[e]);
                    mloc = xhalf_max(mloc);
                    const float mnew = fmaxf(m, mloc);
                    if (__any(mloc - m > 8.f)) {
                        const float alpha = __builtin_amdgcn_exp2f(m - mnew);
                        l *= alpha;
#pragma unroll
                        for (int mt = 0; mt < 8; ++mt)
#pragma unroll
                            for (int e = 0; e < 16; ++e) o[mt][e] *= alpha;
                        m = mnew;
                    }
                    bf16x8 pf[2];
#pragma unroll
                    for (int s2 = 0; s2 < 2; ++s2) {
                        float pe[8];
#pragma unroll
                        for (int e = 0; e < 8; ++e) { pe[e] = __builtin_amdgcn_exp2f(st[8 * s2 + e] - m); l += pe[e]; }
                        u32x4 pw; pw.x = cvt_pk_bf16(pe[0], pe[1]); pw.y = cvt_pk_bf16(pe[2], pe[3]); pw.z = cvt_pk_bf16(pe[4], pe[5]); pw.w = cvt_pk_bf16(pe[6], pe[7]);
                        pf[s2] = __builtin_bit_cast(bf16x8, pw);
                    }
                    __builtin_amdgcn_sched_barrier(0);
#pragma unroll
                    for (int g = 0; g < 4; ++g) {
                        o[2 * g] = __builtin_amdgcn_mfma_f32_32x32x16_bf16(__builtin_bit_cast(bf16x8, vfa[0]), pf[0], o[2 * g], 0, 0, 0);
                        o[2 * g + 1] = __builtin_amdgcn_mfma_f32_32x32x16_bf16(__builtin_bit_cast(bf16x8, vfa[1]), pf[0], o[2 * g + 1], 0, 0, 0);
                        o[2 * g] = __builtin_amdgcn_mfma_f32_32x32x16_bf16(__builtin_bit_cast(bf16x8, vfa[2]), pf[1], o[2 * g], 0, 0, 0);
                        o[2 * g + 1] = __builtin_amdgcn_mfma_f32_32x32x16_bf16(__builtin_bit_cast(bf16x8, vfa[3]), pf[1], o[2 * g + 1], 0, 0, 0);
                        if (g < 3) { AT_LDV(vfa[0], 2 * g + 2, 0); AT_LDV(vfa[1], 2 * g + 3, 0); AT_LDV(vfa[2], 2 * g + 2, 1); AT_LDV(vfa[3], 2 * g + 3, 1); }
                        __builtin_amdgcn_sched_barrier(0);
                    }
#undef AT_LDV
                }
                if (more) {
                    *(LAS u32x4*)(lds + nxt + kw) = rk1; *(LAS u32x4*)(lds + nxt + AT_K2 + kw) = rk2;
                    *(LAS u32x2*)(lds + nxt + vw) = (u32x2){rv0.x, rv0.y}; *(LAS u32x2*)(lds + nxt + vw + 8) = (u32x2){rv0.z, rv0.w};
                    *(LAS u32x2*)(lds + nxt + vw + 128 * AT_VROW) = (u32x2){rv1.x, rv1.y}; *(LAS u32x2*)(lds + nxt + vw + 128 * AT_VROW + 8) = (u32x2){rv1.z, rv1.w};
                }
                __syncthreads();
            }
            l = xhalf_sum(l);
            int r2 = r, h2 = h; asm volatile("" : "+v"(r2), "+v"(h2));
            LAS float* ex = (LAS float*)lds + rg * 8192 + lane;
            if (map == 1) {
                const float sc = lam / l;
#pragma unroll
                for (int mt = 0; mt < 8; ++mt)
#pragma unroll
                    for (int e = 0; e < 16; ++e) ex[(mt * 16 + e) * 64] = o[mt][e] * sc;
            }
            __syncthreads();
            if (map == 0) {
                const float inv = 1.f / l;
                float ssq = 0.f;
#pragma unroll
                for (int mt = 0; mt < 8; ++mt)
#pragma unroll
                    for (int e = 0; e < 16; ++e) { const float v = o[mt][e] * inv - ex[(mt * 16 + e) * 64]; o[mt][e] = v; ssq += v * v; }
                ssq = xhalf_sum(ssq);
                const float rstd = rsqrtf(ssq * (1.f / 256.f) + 1e-5f) * mul;
                const size_t t = (size_t)(b * S_ + q0 + r2);
                const bf16_t* gp = proj + t * ATT_IN + 6144 + hd * 256 + 4 * h2;
                bf16_t* yp = y + t * 2048 + hd * 256 + 4 * h2;
                const float* gs = gsub + 4 * h2;
#pragma unroll
                for (int mt = 0; mt < 8; ++mt)
#pragma unroll
                    for (int g4 = 0; g4 < 4; ++g4) {
                        const int v0 = 32 * mt + 8 * g4;
                        const u32x2 gw = *(const u32x2*)(gp + v0);
                        const f32x4 gg = *(const f32x4*)(gs + v0);
                        u32x2 ow;
                        ow.x = cvt_pk_bf16(o[mt][4 * g4 + 0] * rstd * gg[0] * bflo(gw.x), o[mt][4 * g4 + 1] * rstd * gg[1] * bfhi(gw.x));
                        ow.y = cvt_pk_bf16(o[mt][4 * g4 + 2] * rstd * gg[2] * bflo(gw.y), o[mt][4 * g4 + 3] * rstd * gg[3] * bfhi(gw.y));
                        *(u32x2*)(yp + v0) = ow;
                    }
            }
            __syncthreads();
        }
    }
}


#define XB_TMO      128
#define XB_XCNT(j)  (256  + 64 * (j))
#define XB_XSUB(j)  (1280 + 64 * (j))
#define XB_XGEN(j)  (2304 + 64 * (j))
#define XB_TOP      3328
#define XB_TOPGEN   3392
#define XCD_BAR_WORDS 3456
#define XB_SPIN_CAP (1u << 18)
__device__ __forceinline__ unsigned xb_ld(unsigned* p)              { return __hip_atomic_load(p, __ATOMIC_RELAXED, __HIP_MEMORY_SCOPE_AGENT); }
__device__ __forceinline__ unsigned xb_add(unsigned* p, unsigned v) { return __hip_atomic_fetch_add(p, v, __ATOMIC_RELAXED, __HIP_MEMORY_SCOPE_AGENT); }
__device__ __forceinline__ unsigned xb_xcc_id() { return (unsigned)__builtin_amdgcn_s_getreg((3 << 11) | 20) & 0xFu; }
#define XB_SPIN(cond, bar) do { unsigned _sp = 0; while (cond) { __builtin_amdgcn_s_sleep(1); \
    if ((++_sp & 255u) == 0u) { if (xb_ld(&(bar)[XB_TMO])) break; if (_sp > XB_SPIN_CAP) { atomicAdd(&(bar)[XB_TMO], 1u); break; } } } } while (0)
struct XcdBarrier { unsigned* bar; unsigned x; volatile LAS unsigned* st; unsigned total; };
__device__ __forceinline__ XcdBarrier xcd_barrier_post(unsigned* bar, volatile LAS unsigned* st, unsigned total) {
    XcdBarrier b; b.bar = bar; b.x = xb_xcc_id(); b.st = st; b.total = total;
    if (threadIdx.x == 0) (void)xb_add(&bar[XB_XCNT(b.x)], 1u);
    return b;
}
__device__ __forceinline__ void xcd_barrier_complete(unsigned* bar, unsigned x, unsigned G, unsigned& nloc, unsigned& nx) {
    unsigned sum, cnt, mine, sp = 0u;
    for (;;) {
        sum = 0u; cnt = 0u; mine = 0u;
#pragma unroll
        for (unsigned j = 0; j < 16; ++j) { const unsigned c = xb_ld(&bar[XB_XCNT(j)]); sum += c; cnt += (c > 0u) ? 1u : 0u; mine = (j == x) ? c : mine; }
        if (sum == G) break;
        __builtin_amdgcn_s_sleep(1);
        if ((++sp & 255u) == 0u) { if (xb_ld(&bar[XB_TMO])) break; if (sp > XB_SPIN_CAP) { atomicAdd(&bar[XB_TMO], 1u); break; } }
    }
    nloc = mine > 0u ? mine : 1u; nx = cnt > 0u ? cnt : 1u;
}
__device__ __forceinline__ void xcd_barrier(const XcdBarrier& b) {
    asm volatile("s_waitcnt vmcnt(0)" ::: "memory");
    __syncthreads();
    if (threadIdx.x == 0) {
        unsigned* bar = b.bar;
        __builtin_amdgcn_s_waitcnt(0);
        unsigned nloc = b.st[0], nx = b.st[1];
        if (nloc == 0u) { xcd_barrier_complete(bar, b.x, b.total, nloc, nx); b.st[0] = nloc; b.st[1] = nx; }
        const unsigned old = xb_add(&bar[XB_XSUB(b.x)], 1u);
        const unsigned gen = old / nloc;
        if (old + 1u == (gen + 1u) * nloc) {
            __builtin_amdgcn_fence(__ATOMIC_RELEASE, "agent");
            asm volatile("s_waitcnt vmcnt(0)" ::: "memory");
            const unsigned og = xb_add(&bar[XB_TOP], 1u);
            const unsigned tg = og / nx;
            if (og + 1u == (tg + 1u) * nx) xb_add(&bar[XB_TOPGEN], 1u);
            else XB_SPIN(xb_ld(&bar[XB_TOPGEN]) == tg, bar);
            __builtin_amdgcn_fence(__ATOMIC_ACQUIRE, "agent");
            xb_add(&bar[XB_XGEN(b.x)], 1u);
            asm volatile("s_waitcnt vmcnt(0)" ::: "memory");
        } else {
            XB_SPIN(xb_ld(&bar[XB_XGEN(b.x)]) == gen, bar);
            __builtin_amdgcn_fence(__ATOMIC_ACQUIRE, "agent");
            asm volatile("s_waitcnt vmcnt(0)" ::: "memory");
        }
    }
    __syncthreads();
}
constexpr size_t WS_BAR = WS_SMALL + 32768;
constexpr int LDS_BARST = LDS_BYTES - 16;
constexpr size_t WS_BAR2 = WS_BAR + 16384;
static_assert(true, "");
constexpr int NA_BLOCKS = 64;
static_assert(AT_Q + 8 * 32 * AT_KROW <= LDS_BARST && XCD_BAR_WORDS * 4 + 32768 + 16384 <= 65536, "barrier words");

__device__ __forceinline__ int opaque0() { int z = 0; asm volatile("" : "+s"(z)); return z; }
#define PIN(k) (p.in[(k) + opaque0()])
#define WSP(type, off) ((type*)(ws + (off) + (size_t)opaque0()))

__global__ void __launch_bounds__(NTHR, 2) mega(Params p) {
    extern __shared__ __attribute__((aligned(16))) unsigned char lds_raw[];
    LAS unsigned char* lds = (LAS unsigned char*)lds_raw;
    cg::grid_group grid = cg::this_grid();
    unsigned char* ws = p.ws;
    const int G = gridDim.x;
    const int wid_s = __builtin_amdgcn_readfirstlane(threadIdx.x >> 6);
    int ph = 0;
    const int lo = p.ph_lo, hi = p.ph_hi;
    volatile LAS unsigned* bst = (volatile LAS unsigned*)(lds + LDS_BARST);
    if (threadIdx.x < 4) bst[threadIdx.x] = 0u;
    __syncthreads();
    XcdBarrier xbar = xcd_barrier_post((unsigned*)(ws + WS_BAR), bst, G);
    XcdBarrier xbarB; xbarB.bar = (unsigned*)(ws + WS_BAR2); xbarB.x = xbar.x; xbarB.st = bst + 2; xbarB.total = G - NA_BLOCKS;
    if ((int)blockIdx.x >= NA_BLOCKS) xbarB = xcd_barrier_post((unsigned*)(ws + WS_BAR2), bst + 2, G - NA_BLOCKS);
#ifndef PROBE_DUP
#define PROBE_DUP 0
#endif
#define PHASE_BEGIN_K(kind) if (ph >= lo && ph < hi) { for (int rep = 0; rep <= ((PROBE_DUP >> (kind)) & 1); ++rep) { if (rep) __syncthreads();
#define PHASE_BEGIN PHASE_BEGIN_K(31)
#define PHASE_END   } if (ph + 1 < hi) { if (hi < 0) grid.sync(); else xcd_barrier(xbar); } } ++ph;

    PHASE_BEGIN_K(0)
        const int tid = tid_opaque();
        transpose_w(wid_s, blockIdx.x, G, PIN(2), WSP(bf16_t, WS_W_REC_IN), 2048, REC_IN, (float*)lds_raw);
        {
            const int mt = blockIdx.x >> 3, vbt = blockIdx.x & 7;
            for (int m = mt; m < 32; m += (G + 7) / 8) {
                const int isx = m & 1, hd = (m >> 1) & 7, j = m >> 4;
                const float* src = (isx ? PIN(7) : PIN(5)) + (size_t)(j * 8 + hd) * 65536;
                transpose_w(wid_s, vbt, 8, src, WSP(bf16_t, WS_W_GATE) + (size_t)(j * 16 + hd * 2) * 65536, 256, 256, (float*)lds_raw, 256, 128 * isx);
            }
        }
        float* lb_all = WSP(float, WS_SMALL); float* lamv = lb_all + 4096;
        if (blockIdx.x == 0) {
            const float* hl = PIN(10);
            for (int c = tid; c < 2048; c += NTHR) {
                const float l0 = hl[c], l1 = hl[2048 + c];
                const float m = fmaxf(l0, l1), e0 = __expf(l0 - m), e1 = __expf(l1 - m);
                const float p0 = e0 / (e0 + e1), p1 = e1 / (e0 + e1);
                lb_all[c] = 0.f; lb_all[2048 + c] = (p0 + p1) - p0;
            }
        }
        if (blockIdx.x == 1 && tid < 128) {
            const int j = tid >> 6, lane = tid & 63;
            const float* lp = PIN(17) + j * 512;
            float a1 = lp[lane] * lp[128 + lane] + lp[lane + 64] * lp[128 + lane + 64];
            float a2 = lp[256 + lane] * lp[384 + lane] + lp[256 + lane + 64] * lp[384 + lane + 64];
            a1 = wave_sum(a1); a2 = wave_sum(a2);
            if (lane == 0) lamv[j] = expf(a1) - expf(a2) + p.lam_init[j];
        }
        {
            float* rt = WSP(float, WS_ROPE);
            for (int i = blockIdx.x * NTHR + tid; i < S_ * 16; i += G * NTHR) {
                const int pos = i >> 4, fi = i & 15;
                const float angf = (float)pos * p.inv_freq[fi];
                const double ang = (double)angf;
                const double kk = rint(ang * 0.15915494309189535);
                const float rr = (float)(ang - kk * 6.283185307179586);
                rt[pos * 32 + fi] = cosf(rr); rt[pos * 32 + 16 + fi] = sinf(rr);
            }
        }
        { float* ssz = WSP(float, WS_SS); for (int i = blockIdx.x * NTHR + tid; i < 3 * T_; i += G * NTHR) ssz[i] = 0.f; }
        rmsnorm_phase(wid_s, PIN(0), PIN(1), WSP(bf16_t, WS_H));
    PHASE_END

    for (int layer = 0; layer < 4; ++layer) {
        const int j = layer >> 1;
        if ((layer & 1) == 0) {
            PHASE_BEGIN_K(1)
                pg8::Gemm g{WSP(bf16_t, WS_H), WSP(bf16_t, WS_W_REC_IN) + (size_t)j * REC_IN * 2048, 2048, 2048}; pg8::StaticOrder S; S.init(T_, REC_IN, G, blockIdx.x);
                pg8::EpiRecIn E{WSP(bf16_t, WS_PROJ), WSP(float, WS_S0), WSP(float, WS_SMALL) + j * 2048, layer == 0 ? (const float*)nullptr : WSP(float, WS_SS) + (size_t)(layer - 1) * T_};
                pg8::gemm_phase(wid_s, lds, g, S, E);
            PHASE_END
            PHASE_BEGIN_K(2)
                if ((int)blockIdx.x < NA_BLOCKS) {
                    hgrn_full_phase<NA_BLOCKS == 64 ? 8 : 4>(wid_s, blockIdx.x, WSP(bf16_t, WS_PROJ), WSP(float, WS_S0), WSP(bf16_t, WS_ORAW), PIN(11) + j * 128, WSP(bf16_t, WS_Y), lds);
                } else {
                    const int vb = blockIdx.x - NA_BLOCKS, nb = G - NA_BLOCKS;
                    bf16_t* hb = WSP(bf16_t, WS_H); bf16_t* proj = WSP(bf16_t, WS_PROJ);
                    bf16_t* lab = WSP(bf16_t, WS_S1); bf16_t* ub = lab + (size_t)T_ * 2048;
                    float* sumP = WSP(float, WS_SUM);
                    conv_phase(wid_s, vb, nb, proj, PIN(3) + j * 4 * 2048, PIN(4) + j * 2048, hb);
                    xcd_barrier(xbarB);
                    {
                        pg8::Gemm g{hb, WSP(bf16_t, WS_W_GATE) + (size_t)j * 16 * 256 * 256, 2048, 256 + opaque0()}; pg8::GateOrder S{nb, vb};
                        pg8::EpiGate E{hb, PIN(6) + j * 2048, PIN(8) + j * 2048, PIN(9) + j * 2048, lab, ub};
                        pg8::gemm_phase(wid_s, lds, g, S, E);
                    }
                    xcd_barrier(xbarB);
                    scan_a_phase(wid_s, vb, nb, lab, ub, sumP, sumP + NB_ * 32 * 2048);
                    xcd_barrier(xbarB);
                    scan_b_phase(wid_s, vb, nb, lab, ub, sumP, sumP + NB_ * 32 * 2048, proj, WSP(bf16_t, WS_Y));
                    __syncthreads();
                    transpose_w(wid_s, vb, nb, PIN(14) + (size_t)j * 2048 * ATT_IN, WSP(bf16_t, WS_W_ATT_IN) + (size_t)j * ATT_IN * 2048, 2048, ATT_IN, (float*)lds_raw);
                    transpose_w(wid_s, vb, nb, PIN(19) + (size_t)j * 2048 * 2048, WSP(bf16_t, WS_W_ATT_OUT) + (size_t)j * 2048 * 2048, 2048, 2048, (float*)lds_raw);
                    if (j == 0) {
                        transpose_w(wid_s, vb, nb, PIN(12), WSP(bf16_t, WS_W_REC_OUT), REC_OUT, 2048, (float*)lds_raw);
                        transpose_w(wid_s, vb, nb, PIN(2) + (size_t)2048 * REC_IN, WSP(bf16_t, WS_W_REC_IN) + (size_t)REC_IN * 2048, 2048, REC_IN, (float*)lds_raw);
                        transpose_w(wid_s, vb, nb, PIN(12) + (size_t)REC_OUT * 2048, WSP(bf16_t, WS_W_REC_OUT) + (size_t)2048 * REC_OUT, REC_OUT, 2048, (float*)lds_raw);
                    }
                }
            PHASE_END
        } else {
            PHASE_BEGIN_K(7)
                pg8::Gemm g{WSP(bf16_t, WS_H), WSP(bf16_t, WS_W_ATT_IN) + (size_t)j * ATT_IN * 2048, 2048, 2048}; pg8::StaticOrder S; S.init(T_, ATT_IN, G, blockIdx.x);
                pg8::EpiAttIn E{WSP(bf16_t, WS_PROJ), WSP(float, WS_SS) + (size_t)(layer - 1) * T_, PIN(15) + j * 128, PIN(16) + j * 128, WSP(float, WS_ROPE), WSP(bf16_t, WS_S0), lds + 131072};
                pg8::gemm_phase(wid_s, lds, g, S, E);
            PHASE_END
            PHASE_BEGIN_K(9)
                                attn_phase(wid_s, WSP(bf16_t, WS_PROJ), WSP(const bf16_t, WS_S0), WSP(float, WS_SMALL) + 4096 + j, PIN(18) + j * 256, 1.f - p.lam_init[j], WSP(bf16_t, WS_Y), lds);
            PHASE_END
        }
        PHASE_BEGIN_K(10)
            const bool rec = (layer & 1) == 0;
            const int Ko = rec ? REC_OUT : 2048;
            float* xbuf = WSP(float, WS_X);
            const float* xres = layer == 0 ? PIN(0) : xbuf;
            float* xdst = layer == 3 ? p.out : xbuf;
            pg8::Gemm g{WSP(bf16_t, WS_Y), rec ? WSP(bf16_t, WS_W_REC_OUT) + (size_t)j * 2048 * REC_OUT : WSP(bf16_t, WS_W_ATT_OUT) + (size_t)j * 2048 * 2048, Ko, Ko}; pg8::StaticOrder S; S.init(T_, 2048, G, blockIdx.x);
            const int nl = layer + 1;
            const float* gn = layer == 3 ? (const float*)nullptr : ((nl & 1) ? PIN(13) + (nl >> 1) * 2048 : PIN(1) + (nl >> 1) * 2048);
            pg8::EpiResid E{xres, xdst, gn, WSP(bf16_t, WS_H), WSP(float, WS_SS) + (size_t)layer * T_};
            pg8::gemm_phase(wid_s, lds, g, S, E);
        PHASE_END
    }
}

constexpr int N_PHASES = 1 + 3 + 3 + 3 + 3;

extern "C" void kernel_launch(void* const* d_in, const int* in_sizes, int n_in, void* d_out, int out_size, void* d_ws, size_t ws_size, hipStream_t stream) {
    static int grid = 0;
    if (grid == 0) {
        if (n_in != 20 || ws_size < WS_END) { fprintf(stderr, "kernel_launch: bad inputs (n_in %d, ws %zu < %zu)\n", n_in, ws_size, (size_t)WS_END); grid = -1; return; }
        int dev = 0, cus = 0, per_cu = 0;
        if (hipGetDevice(&dev) != hipSuccess || hipDeviceGetAttribute(&cus, hipDeviceAttributeMultiprocessorCount, dev) != hipSuccess) { grid = -1; return; }
        if (hipFuncSetAttribute((const void*)mega, hipFuncAttributeMaxDynamicSharedMemorySize, LDS_BYTES) != hipSuccess) { fprintf(stderr, "hipFuncSetAttribute failed\n"); grid = -1; return; }
        if (hipOccupancyMaxActiveBlocksPerMultiprocessor(&per_cu, (const void*)mega, NTHR, LDS_BYTES) != hipSuccess || per_cu < 1) { fprintf(stderr, "occupancy query failed (%d)\n", per_cu); grid = -1; return; }
        grid = cus * per_cu;
        if (grid > 256) grid = 256;
        if (grid != 256) { fprintf(stderr, "kernel_launch: this kernel needs exactly 256 resident workgroups (got %d)\n", grid); grid = -1; return; }
    }
    if (grid < 0) return;
    Params p;
    memset(&p, 0, sizeof(p));
    for (int i = 0; i < 20; ++i) p.in[i] = (const float*)d_in[i];
    p.out = (float*)d_out; p.ws = (unsigned char*)d_ws;
    for (int i = 0; i < 16; ++i) p.inv_freq[i] = (float)pow(500000.0, -(double)(2 * i) / 32.0);
    p.lam_init[0] = (float)(0.8 - 0.6 * exp(-0.3 * 1.0));
    p.lam_init[1] = (float)(0.8 - 0.6 * exp(-0.3 * 3.0));
    p.ph_lo = 0; p.ph_hi = N_PHASES;
    if (hipMemsetAsync((unsigned char*)d_ws + WS_BAR, 0, 16384 + XCD_BAR_WORDS * 4, stream) != hipSuccess) { fprintf(stderr, "memset of barrier words failed\n"); return; }
    void* args[] = {&p};
    hipError_t e = hipLaunchCooperativeKernel((const void*)mega, dim3(grid), dim3(NTHR), args, LDS_BYTES, stream);
    if (e != hipSuccess) fprintf(stderr, "cooperative launch failed: %s (grid %d)\n", hipGetErrorString(e), grid);
}
```

```cpp
#include <hip/hip_runtime.h>
#include <hip/hip_cooperative_groups.h>
#include <cstdio>
#include <cstdint>
#include <cmath>
#include <cstring>
namespace cg = cooperative_groups;

#define LAS __attribute__((address_space(3)))
typedef unsigned short bf16_t;
typedef short bf16x8 __attribute__((ext_vector_type(8)));
typedef float f32x4 __attribute__((ext_vector_type(4)));
typedef float f32x2 __attribute__((ext_vector_type(2)));
typedef unsigned u32x4 __attribute__((ext_vector_type(4)));
typedef unsigned u32x2 __attribute__((ext_vector_type(2)));

constexpr int T_ = 8192, S_ = 2048, NB_ = 4;
constexpr int REC_IN = 12288, REC_OUT = 4096, ATT_IN = 8192;
constexpr int NTHR = 512;
constexpr int LDS_BYTES = 147456;

constexpr size_t SZ_W_REC_IN = (size_t)2 * REC_IN * 2048 * 2, SZ_W_REC_OUT = (size_t)2 * 2048 * REC_OUT * 2, SZ_W_ATT_IN = (size_t)2 * ATT_IN * 2048 * 2,
                 SZ_W_ATT_OUT = (size_t)2 * 2048 * 2048 * 2, SZ_W_GATE = (size_t)2 * 16 * 256 * 256 * 2;
constexpr size_t WS_W_REC_IN = 0, WS_W_REC_OUT = WS_W_REC_IN + SZ_W_REC_IN, WS_W_ATT_IN = WS_W_REC_OUT + SZ_W_REC_OUT, WS_W_ATT_OUT = WS_W_ATT_IN + SZ_W_ATT_IN,
                 WS_W_GATE = WS_W_ATT_OUT + SZ_W_ATT_OUT;
constexpr size_t WS_X = WS_W_GATE + SZ_W_GATE;
constexpr size_t WS_H = WS_X + (size_t)T_ * 2048 * 4;
constexpr size_t WS_PROJ = WS_H + (size_t)T_ * 2048 * 2;
constexpr size_t WS_S0 = WS_PROJ + (size_t)T_ * REC_IN * 2;
constexpr size_t WS_S1 = WS_S0 + (size_t)T_ * 2048 * 4;
constexpr size_t WS_ORAW = WS_S1 + (size_t)T_ * 2048 * 4;
constexpr size_t WS_Y = WS_ORAW + (size_t)T_ * 2048 * 2;
constexpr size_t WS_SUM = WS_Y + (size_t)T_ * REC_OUT * 2;
constexpr size_t WS_SMALL = WS_SUM + (size_t)2 * 4 * 32 * 2048 * 4;
constexpr size_t WS_SS = WS_SMALL + 65536;
constexpr size_t WS_ROPE = WS_SS + (size_t)3 * T_ * 4;
constexpr size_t WS_END = WS_ROPE + (size_t)S_ * 32 * 4;

struct Params {
    const float* in[20];
    float* out;
    unsigned char* ws;
    float inv_freq[16];
    float lam_init[2];
    int ph_lo, ph_hi;
};

__device__ __forceinline__ float bf2f(unsigned v) { return __uint_as_float(v << 16); }
__device__ __forceinline__ unsigned cvt_pk_bf16(float lo, float hi) { unsigned r; asm volatile("v_cvt_pk_bf16_f32 %0, %1, %2" : "=v"(r) : "v"(lo), "v"(hi)); return r; }
typedef __bf16 bf16pair_t __attribute__((ext_vector_type(2)));
__device__ __forceinline__ unsigned cvt_pk_bf16_v(float lo, float hi) { const f32x2 v = {lo, hi}; return __builtin_bit_cast(unsigned, __builtin_convertvector(v, bf16pair_t)); }
__device__ __forceinline__ float bflo(unsigned w) { return __uint_as_float(w << 16); }
__device__ __forceinline__ float bfhi(unsigned w) { return __uint_as_float(w & 0xffff0000u); }
__device__ __forceinline__ float sigmoidf_(float x) { return __builtin_amdgcn_rcpf(1.f + __expf(-x)); }
__device__ __forceinline__ float siluf_(float x) { return x * __builtin_amdgcn_rcpf(1.f + __expf(-x)); }
__device__ __forceinline__ float wave_sum(float v) {
#pragma unroll
    for (int o = 32; o > 0; o >>= 1) v += __shfl_xor(v, o);
    return v;
}
__device__ __forceinline__ float wave_max(float v) {
#pragma unroll
    for (int o = 32; o > 0; o >>= 1) v = fmaxf(v, __shfl_xor(v, o));
    return v;
}

__device__ __forceinline__ float neg_expm1(float y) {
    const float ser = -y * (1.f + y * (0.5f + y * (0.16666667f + y * (0.041666668f + y * 0.0083333338f))));
    return y > -0.25f ? ser : 1.f - __expf(y);
}
__device__ __forceinline__ int lane_fresh() { int l; asm volatile("v_mbcnt_lo_u32_b32 %0, -1, 0\n\tv_mbcnt_hi_u32_b32 %0, -1, %0" : "=v"(l)); return l; }
#define tid_opaque() (wid_s * 64 + lane_fresh())

namespace pg8 {
constexpr int BM = 256, BK = 64, HALF = 128, HTB = HALF * BK * 2, STAGE_BYTES = 8 * HTB, NXCD = 8, WGM = 8;
__host__ __device__ __forceinline__ int lds_byte(int r, int c) { const int st = (r >> 4) * 2 + (c >> 5), rr = r & 15, cc = c & 31, ob = rr * 64 + cc * 2; return st * 1024 + (ob ^ (((ob >> 9) & 1) << 5)); }
__host__ __device__ __forceinline__ void stage_rc(int b, int& R, int& C) { const int st = b / 1024, sb = b % 1024, swz = sb ^ (((sb >> 9) & 1) << 5); R = (st >> 1) * 16 + swz / 64; C = (st & 1) * 32 + (swz % 64) / 2; }
__host__ __device__ __forceinline__ int perm32(int rho) { const int n = rho >> 4, i = rho & 15; return 8 * (i >> 2) + 4 * n + (i & 3); }

struct Unit { int pm, pn, kofs; };
struct Gemm { const bf16_t* A; const bf16_t* Bt; int lda, K; };

struct StaticOrder {
    int nM, nN, nwg, G, c;
    __device__ void init(int M, int N, int G_, int c_) { nM = M / BM; nN = N / BM; nwg = nM * nN; G = G_; c = c_; }
    __device__ bool next(int i, Unit& u) const {
        const long L = (long)i * G + c; if (L >= nwg) return false;
        int wgid = (int)L; { const int q = nwg / NXCD, r = nwg % NXCD, xcd = wgid % NXCD, off = wgid / NXCD; wgid = (xcd < r ? xcd * (q + 1) : r * (q + 1) + (xcd - r) * q) + off; }
        const int nig = WGM * nN, gid = wgid / nig, fm = gid * WGM, gsz = (nM - fm) < WGM ? (nM - fm) : WGM;
        u.pm = fm + ((wgid % nig) % gsz); u.pn = (wgid % nig) / gsz; u.kofs = 0; return true;
    }
};
struct GateOrder {
    int G, c;
    __device__ bool next(int i, Unit& u) const {
        const int L = i * G + c; if (L >= 512) return false;
        u.pm = L & 31; u.pn = L >> 5; u.kofs = (u.pn >> 1) * 256; return true;
    }
};

template <class Epi, class Sched>
__device__ __forceinline__ void gemm_phase(const int wid_s, LAS unsigned char* lds, const Gemm g, const Sched& S, const Epi& E) {
    const int lane = lane_fresh(), wid = wid_s, tid = wid * 64 + lane; const int wr = wid >> 2, wc = wid & 3, fr = lane & 15, fq = lane >> 4;
    const int K = g.K, lda = g.lda, nt = K / BK;
    unsigned voffA[2], voffB[2];
#pragma unroll
    for (int i = 0; i < 2; ++i) { int R, C; stage_rc(tid * 16 + i * 8192, R, C); const int Rb = (R & ~31) + perm32(R & 31);
        voffA[i] = (unsigned)(R * lda + C) * 2u; voffB[i] = (unsigned)(Rb * K + C) * 2u; }
    const size_t kstep = (size_t)(BK * 2);
    const size_t hstepA = (size_t)HALF * lda * 2, hstepB = (size_t)HALF * K * 2;
    const size_t tstepA = 2 * hstepA, tstepB = 2 * hstepB;
    const unsigned ldsw = (unsigned)wid * 1024u;
    const int aoff = lds_byte(wr * 64 + fr, fq * 8), boff = lds_byte(wc * 32 + fr, fq * 8);
#define PG8_SA(b, h) (((b) * 2 + (h)) * HTB)
#define PG8_SB(b, h) ((4 + (b) * 2 + (h)) * HTB)
#define PG8_STAGE(bufoff, gbase, voff) do { _Pragma("unroll") for (int _i = 0; _i < 2; ++_i) \
        __builtin_amdgcn_global_load_lds((const unsigned*)((const char*)(gbase) + (voff)[_i]), (LAS unsigned*)(lds + (bufoff) + ldsw + _i * 8192), 16, 0, 0); } while (0)
#define PG8_LDA(dst, b, h) do { _Pragma("unroll") for (int m = 0; m < 4; ++m) _Pragma("unroll") for (int k = 0; k < 2; ++k) dst[m][k] = *(const LAS bf16x8*)(lds + PG8_SA(b, h) + aoff + m * 2048 + k * 1024); } while (0)
#define PG8_LDB(dst, b, h) do { _Pragma("unroll") for (int n = 0; n < 2; ++n) _Pragma("unroll") for (int k = 0; k < 2; ++k) dst[n][k] = *(const LAS bf16x8*)(lds + PG8_SB(b, h) + boff + n * 2048 + k * 1024); } while (0)
#define PG8_MMA(ai, bj, At, Bt) do { __builtin_amdgcn_s_setprio(1); _Pragma("unroll") for (int m = 0; m < 4; ++m) _Pragma("unroll") for (int n = 0; n < 2; ++n) _Pragma("unroll") for (int k = 0; k < 2; ++k) \
        acc[ai][bj][m][n] = __builtin_amdgcn_mfma_f32_16x16x32_bf16(Bt[n][k], At[m][k], acc[ai][bj][m][n], 0, 0, 0); __builtin_amdgcn_s_setprio(0); } while (0)
#define PG8_WAIT_V(n) asm volatile("s_waitcnt vmcnt(" #n ")" ::: "memory")
#define PG8_WAIT_L(n) asm volatile("s_waitcnt lgkmcnt(" #n ")" ::: "memory")
#define PG8_BAR __builtin_amdgcn_s_barrier()
#define PG8_SCHED __builtin_amdgcn_sched_barrier(0)
    Unit cur, nxt; int ui = 0;
    if (!S.next(0, cur)) return;
    f32x4 acc[2][2][4][2];
#pragma unroll
    for (int a = 0; a < 2; ++a)
#pragma unroll
        for (int b = 0; b < 2; ++b)
#pragma unroll
            for (int m = 0; m < 4; ++m)
#pragma unroll
                for (int n = 0; n < 2; ++n) acc[a][b][m][n] = (f32x4){0.f, 0.f, 0.f, 0.f};
    bf16x8 At[4][2], B0[2][2], B1[2][2];
    const char* cA = (const char*)g.A + (size_t)cur.pm * tstepA + (size_t)cur.kofs * 2; const char* cB = (const char*)g.Bt + (size_t)cur.pn * tstepB;
    {
        PG8_STAGE(PG8_SB(0, 0), cB, voffB); PG8_STAGE(PG8_SB(0, 1), cB + hstepB, voffB); PG8_STAGE(PG8_SA(0, 0), cA, voffA); PG8_STAGE(PG8_SA(0, 1), cA + hstepA, voffA);
        if (wr == 1) PG8_BAR;
        PG8_WAIT_V(2); PG8_BAR;
        PG8_STAGE(PG8_SB(1, 0), cB + kstep, voffB); PG8_STAGE(PG8_SA(1, 0), cA + kstep, voffA); PG8_STAGE(PG8_SB(1, 1), cB + hstepB + kstep, voffB);
        PG8_WAIT_V(6); PG8_BAR;
    }
    for (;;) {
        const bool has_next = S.next(ui + 1, nxt);
        const char* nA = has_next ? (const char*)g.A + (size_t)nxt.pm * tstepA + (size_t)nxt.kofs * 2 : cA; const char* nB = has_next ? (const char*)g.Bt + (size_t)nxt.pn * tstepB : cB;
        for (int t = 0; t < nt; t += 2) {
            const bool last = (t == nt - 2);
            const char* a1 = cA + (size_t)(t + 1) * kstep;
            const char* a2 = last ? nA : cA + (size_t)(t + 2) * kstep; const char* b2 = last ? nB : cB + (size_t)(t + 2) * kstep;
            const char* a3 = a2 + kstep; const char* b3 = b2 + kstep;
            PG8_LDB(B0, 0, 0); PG8_LDB(B1, 0, 1); PG8_SCHED; PG8_LDA(At, 0, 0); PG8_STAGE(PG8_SA(1, 1), a1 + hstepA, voffA);
            PG8_WAIT_V(8); PG8_WAIT_L(0); PG8_BAR; PG8_MMA(0, 0, At, B0); PG8_MMA(0, 1, At, B1); PG8_BAR; PG8_SCHED;
            PG8_LDA(At, 0, 1); PG8_STAGE(PG8_SB(0, 0), b2, voffB); PG8_STAGE(PG8_SB(0, 1), b2 + hstepB, voffB); PG8_STAGE(PG8_SA(0, 0), a2, voffA);
            PG8_WAIT_V(8); PG8_WAIT_L(0); PG8_BAR; PG8_MMA(1, 0, At, B0); PG8_MMA(1, 1, At, B1); PG8_BAR; PG8_SCHED;
            PG8_LDB(B0, 1, 0); PG8_LDB(B1, 1, 1); PG8_SCHED; PG8_LDA(At, 1, 0); PG8_STAGE(PG8_SA(0, 1), a2 + hstepA, voffA);
            PG8_WAIT_V(8); PG8_WAIT_L(0); PG8_BAR; PG8_MMA(0, 0, At, B0); PG8_MMA(0, 1, At, B1); PG8_BAR; PG8_SCHED;
            PG8_LDA(At, 1, 1); PG8_STAGE(PG8_SB(1, 0), b3, voffB); PG8_STAGE(PG8_SB(1, 1), b3 + hstepB, voffB); PG8_STAGE(PG8_SA(1, 0), a3, voffA);
            PG8_WAIT_V(8); PG8_WAIT_L(0); PG8_BAR; PG8_MMA(1, 0, At, B0); PG8_MMA(1, 1, At, B1); PG8_BAR; PG8_SCHED;
        }
        if (wr == 0) PG8_BAR;
        { const int l2 = lane_fresh(); E(acc, cur, wr, wc, l2 & 15, l2 >> 4); }
        if (!has_next) break;
#pragma unroll
        for (int a = 0; a < 2; ++a)
#pragma unroll
            for (int b = 0; b < 2; ++b)
#pragma unroll
                for (int m = 0; m < 4; ++m)
#pragma unroll
                    for (int n = 0; n < 2; ++n) acc[a][b][m][n] = (f32x4){0.f, 0.f, 0.f, 0.f};
        cur = nxt; cA = nA; cB = nB; ++ui;
        if (wr == 1) PG8_BAR;
    }
    PG8_WAIT_V(0);
    PG8_BAR;
#undef PG8_SA
#undef PG8_SB
#undef PG8_STAGE
#undef PG8_LDA
#undef PG8_LDB
#undef PG8_MMA
#undef PG8_WAIT_V
#undef PG8_WAIT_L
#undef PG8_BAR
#undef PG8_SCHED
}

__device__ __forceinline__ void store8_bf16(bf16_t* p, f32x4 v0, f32x4 v1) {
    u32x4 w; w.x = cvt_pk_bf16(v0[0], v0[1]); w.y = cvt_pk_bf16(v0[2], v0[3]); w.z = cvt_pk_bf16(v1[0], v1[1]); w.w = cvt_pk_bf16(v1[2], v1[3]);
    *(u32x4*)p = w;
}
__device__ __forceinline__ f32x4 silu4(f32x4 v, float s) { f32x4 r; r[0] = siluf_(v[0]) * s; r[1] = siluf_(v[1]) * s; r[2] = siluf_(v[2]) * s; r[3] = siluf_(v[3]) * s; return r; }
__device__ __forceinline__ float logf_gate(float v, float lb) {
    const float ls = fminf(v, 0.f) - __logf(1.f + __expf(-fabsf(v)));
    return lb > 0.f ? __logf(lb + (1.f - lb) * __expf(ls)) : ls;
}

struct EpiRecIn {
    bf16_t* proj; float* logfb; const float* lb; const float* ssq;
    __device__ __forceinline__ void operator()(const f32x4 (&acc)[2][2][4][2], const Unit& u, int wr, int wc, int fr, int fq) const {
        const int row0 = u.pm * BM + wr * 64 + fr, colt = u.pn * BM, seg = colt >> 11, col0 = colt + wc * 32 + 8 * fq;
#pragma unroll
        for (int ai = 0; ai < 2; ++ai)
#pragma unroll
            for (int m = 0; m < 4; ++m) {
                const size_t row = (size_t)(row0 + ai * HALF + m * 16);
                const float rs = ssq ? rsqrtf(ssq[row] * (1.f / 2048.f) + 1e-6f) : 1.f;
#pragma unroll
                for (int bj = 0; bj < 2; ++bj) {
                    const int c = col0 + bj * HALF;
                    f32x4 v0 = acc[ai][bj][m][0] * rs, v1 = acc[ai][bj][m][1] * rs;
                    if (seg == 3) {
                        const int cc = c - 6144;
                        const f32x4 l0 = *(const f32x4*)(lb + cc), l1 = *(const f32x4*)(lb + cc + 4);
                        f32x4 o0, o1;
                        f32x4 k0, k1;
#pragma unroll
                        for (int e = 0; e < 4; ++e) { o0[e] = logf_gate(v0[e], l0[e]) * 1.4426950408889634f; o1[e] = logf_gate(v1[e], l1[e]) * 1.4426950408889634f;     k0[e] = (1.f - l0[e]) * sigmoidf_(-v0[e]); k1[e] = (1.f - l1[e]) * sigmoidf_(-v1[e]); }
                        *(f32x4*)(logfb + row * 2048 + cc) = o0; *(f32x4*)(logfb + row * 2048 + cc + 4) = o1;
                        store8_bf16(proj + row * REC_IN + c, k0, k1);
                    } else {
                        if (seg == 1 || seg == 5) { v0 = silu4(v0, 1.f); v1 = silu4(v1, 1.f); }
                        else if (seg == 2) { v0 = silu4(v0, 0.08838834764831845f); v1 = silu4(v1, 0.08838834764831845f); }
                        store8_bf16(proj + row * REC_IN + c, v0, v1);
                    }
                }
            }
    }
};
struct EpiAttIn {
    bf16_t* proj; const float* ssq; const float* qn; const float* kn; const float* ropetab; bf16_t* vT; LAS unsigned char* xlds;
    __device__ __forceinline__ void operator()(const f32x4 (&acc)[2][2][4][2], const Unit& u, int wr, int wc, int fr, int fq) const {
        const int row0 = u.pm * BM + wr * 64 + fr, colt = u.pn * BM, seg = colt >> 11, col0 = colt + wc * 32 + 8 * fq;
        if (seg < 2) {
            LAS float* xs = (LAS float*)xlds;
            float rsv[2][4];
#pragma unroll
            for (int ai = 0; ai < 2; ++ai)
#pragma unroll
                for (int m = 0; m < 4; ++m) {
                    const int rl = wr * 64 + ai * HALF + m * 16 + fr;
                    const float rs = rsqrtf(ssq[(size_t)(u.pm * BM + rl)] * (1.f / 2048.f) + 1e-6f);
                    rsv[ai][m] = rs;
#pragma unroll
                    for (int bj = 0; bj < 2; ++bj) {
                        const f32x4 a0 = acc[ai][bj][m][0] * rs, a1 = acc[ai][bj][m][1] * rs;
                        float ps = a0[0] * a0[0] + a0[1] * a0[1] + a0[2] * a0[2] + a0[3] * a0[3] + a1[0] * a1[0] + a1[1] * a1[1] + a1[2] * a1[2] + a1[3] * a1[3];
                        ps += __shfl_xor(ps, 16); ps += __shfl_xor(ps, 32);
                        if (fq == 0) xs[(rl * 2 + bj) * 4 + wc] = ps;
                    }
                }
            asm volatile("s_waitcnt lgkmcnt(0)" ::: "memory");
            __builtin_amdgcn_s_barrier();
            asm volatile("" ::: "memory");
            const float* gw = (seg == 0 ? qn : kn) + wc * 32 + 8 * fq;
            const f32x4 g0 = *(const f32x4*)gw, g1 = *(const f32x4*)(gw + 4);
            const float qs = seg == 0 ? 0.12751743f : 1.f;
#pragma unroll
            for (int ai = 0; ai < 2; ++ai)
#pragma unroll
                for (int m = 0; m < 4; ++m) {
                    const int rl = wr * 64 + ai * HALF + m * 16 + fr;
                    const size_t row = (size_t)(u.pm * BM + rl);
                    f32x4 c0 = (f32x4){1.f, 1.f, 1.f, 1.f}, c1 = c0, s0 = (f32x4){0.f, 0.f, 0.f, 0.f}, s1 = s0;
                    if (wc == 0) {
                        const float* rp = ropetab + (size_t)(row & (S_ - 1)) * 32 + (fq & 1) * 8;
                        c0 = *(const f32x4*)rp; c1 = *(const f32x4*)(rp + 4); s0 = *(const f32x4*)(rp + 16); s1 = *(const f32x4*)(rp + 20);
                        if (fq < 2) { s0 = -s0; s1 = -s1; }
                    }
#pragma unroll
                    for (int bj = 0; bj < 2; ++bj) {
                        const f32x4 pv = *(const LAS f32x4*)(xs + (rl * 2 + bj) * 4);
                        const float rstd = rsqrtf((pv[0] + pv[1] + pv[2] + pv[3]) * (1.f / 128.f) + 1e-6f) * qs;
                        f32x4 v0 = acc[ai][bj][m][0] * rsv[ai][m] * g0, v1 = acc[ai][bj][m][1] * rsv[ai][m] * g1;
                        if (wc == 0) {
                            f32x4 o0, o1;
#pragma unroll
                            for (int e = 0; e < 4; ++e) { o0[e] = __shfl_xor(v0[e], 32); o1[e] = __shfl_xor(v1[e], 32); }
                            v0 = v0 * c0 + o0 * s0; v1 = v1 * c1 + o1 * s1;
                        }
                        store8_bf16(proj + row * ATT_IN + col0 + bj * HALF, v0 * rstd, v1 * rstd);
                    }
                }
        } else if (seg == 2) {
#pragma unroll
            for (int ai = 0; ai < 2; ++ai)
#pragma unroll
                for (int m = 0; m < 4; ++m) {
                    const int row = row0 + ai * HALF + m * 16;
                    const float rs = rsqrtf(ssq[row] * (1.f / 2048.f) + 1e-6f);
                    const int bb = row >> 11, sp = row & (S_ - 1);
#pragma unroll
                    for (int bj = 0; bj < 2; ++bj) {
                        const int c = col0 + bj * HALF - 4096;
                        bf16_t* dst = vT + ((size_t)(bb * 8) * 256 + c) * S_ + sp;
                        const f32x4 a0 = acc[ai][bj][m][0] * rs, a1 = acc[ai][bj][m][1] * rs;
                        const unsigned w0 = cvt_pk_bf16(a0[0], a0[1]), w1 = cvt_pk_bf16(a0[2], a0[3]), w2 = cvt_pk_bf16(a1[0], a1[1]), w3 = cvt_pk_bf16(a1[2], a1[3]);
                        dst[0] = (bf16_t)(w0 & 0xffffu); dst[S_] = (bf16_t)(w0 >> 16); dst[2 * S_] = (bf16_t)(w1 & 0xffffu); dst[3 * S_] = (bf16_t)(w1 >> 16);
                        dst[4 * S_] = (bf16_t)(w2 & 0xffffu); dst[5 * S_] = (bf16_t)(w2 >> 16); dst[6 * S_] = (bf16_t)(w3 & 0xffffu); dst[7 * S_] = (bf16_t)(w3 >> 16);
                    }
                }
        } else {
#pragma unroll
            for (int ai = 0; ai < 2; ++ai)
#pragma unroll
                for (int m = 0; m < 4; ++m) {
                    const size_t row = (size_t)(row0 + ai * HALF + m * 16);
                    const float rs = rsqrtf(ssq[row] * (1.f / 2048.f) + 1e-6f);
#pragma unroll
                    for (int bj = 0; bj < 2; ++bj)
                        store8_bf16(proj + row * ATT_IN + col0 + bj * HALF, silu4(acc[ai][bj][m][0] * rs, 1.f), silu4(acc[ai][bj][m][1] * rs, 1.f));
                }
        }
    }
};
struct EpiResid {
    const float* xin; float* xout; const float* gnext; bf16_t* hnext; float* ssq;
    __device__ __forceinline__ void operator()(const f32x4 (&acc)[2][2][4][2], const Unit& u, int wr, int wc, int fr, int fq) const {
        const int row0 = u.pm * BM + wr * 64 + fr, col0 = u.pn * BM + wc * 32 + 8 * fq;
        const bool nx = gnext != nullptr;
#pragma unroll
        for (int ai = 0; ai < 2; ++ai)
#pragma unroll
            for (int m = 0; m < 4; ++m) {
                const size_t row = (size_t)(row0 + ai * HALF + m * 16);
                float ps = 0.f;
#pragma unroll
                for (int bj = 0; bj < 2; ++bj) {
                    const size_t idx = row * 2048 + col0 + bj * HALF;
                    const f32x4 x0 = *(const f32x4*)(xin + idx) + acc[ai][bj][m][0], x1 = *(const f32x4*)(xin + idx + 4) + acc[ai][bj][m][1];
                    *(f32x4*)(xout + idx) = x0; *(f32x4*)(xout + idx + 4) = x1;
                    if (nx) {
                        const f32x4 g0 = *(const f32x4*)(gnext + col0 + bj * HALF), g1 = *(const f32x4*)(gnext + col0 + bj * HALF + 4);
                        store8_bf16(hnext + idx, x0 * g0, x1 * g1);
                        ps += x0[0] * x0[0] + x0[1] * x0[1] + x0[2] * x0[2] + x0[3] * x0[3] + x1[0] * x1[0] + x1[1] * x1[1] + x1[2] * x1[2] + x1[3] * x1[3];
                    }
                }
                if (nx) {
                    ps += __shfl_xor(ps, 16); ps += __shfl_xor(ps, 32);
                    if (fq == 0) (void)__hip_atomic_fetch_add(ssq + row, ps, __ATOMIC_RELAXED, __HIP_MEMORY_SCOPE_AGENT);
                }
            }
    }
};
struct EpiGate {
    const bf16_t* xc; const float* ba; const float* bx; const float* lam; bf16_t* a_out; bf16_t* u_out;
    __device__ __forceinline__ void operator()(const f32x4 (&acc)[2][2][4][2], const Unit& u, int wr, int wc, int fr, int fq) const {
        const int row0 = u.pm * BM + wr * 64 + fr;
        const int c0 = (u.pn >> 1) * 256 + (u.pn & 1) * 128 + wc * 32 + 8 * fq;
        float bav[8], bxv[8], spv[8];
#pragma unroll
        for (int e = 0; e < 8; ++e) { bav[e] = ba[c0 + e]; bxv[e] = bx[c0 + e]; const float l = lam[c0 + e]; spv[e] = -8.f * (fmaxf(-l, 0.f) + __logf(1.f + __expf(-fabsf(l)))); }
#pragma unroll
        for (int ai = 0; ai < 2; ++ai)
#pragma unroll
            for (int m = 0; m < 4; ++m) {
                const size_t idx = (size_t)(row0 + ai * HALF + m * 16) * 2048 + c0;
                const u32x4 xw = *(const u32x4*)(xc + idx);
                float xv[8] = {bflo(xw.x), bfhi(xw.x), bflo(xw.y), bfhi(xw.y), bflo(xw.z), bfhi(xw.z), bflo(xw.w), bfhi(xw.w)};
                f32x4 ao[2], uo[2];
#pragma unroll
                for (int n = 0; n < 2; ++n)
#pragma unroll
                    for (int e = 0; e < 4; ++e) {
                        const int q = n * 4 + e;
                        const float r = sigmoidf_(acc[ai][0][m][n][e] + bav[q]), ig = sigmoidf_(acc[ai][1][m][n][e] + bxv[q]);
                        const float log_a = r * spv[q];
                        ao[n][e] = log_a;
                        uo[n][e] = __builtin_amdgcn_sqrtf(neg_expm1(2.f * log_a)) * (ig * xv[q]);
                    }
                store8_bf16(a_out + idx, ao[0], ao[1]);
                store8_bf16(u_out + idx, uo[0], uo[1]);
            }
    }
};
}

__device__ void transpose_w(const int wid_s, const int vb, const int nb, const float* __restrict__ W, bf16_t* __restrict__ Wt, int K, int N, float* sm, const int rs_hi = 128, const int rs_off = 0) {
    const int tidx = tid_opaque();
    const int tid = tidx, tn = N / 128, ntile = (K / 64) * tn;
    for (int tile = vb; tile < ntile; tile += nb) {
        const int k0 = (tile / tn) * 64, n0 = (tile % tn) * 128;
        f32x4 v[4];
#pragma unroll
        for (int i = 0; i < 4; ++i) v[i] = __builtin_nontemporal_load((const f32x4*)(W + (size_t)(k0 + (tid >> 5) + 16 * i) * N + n0 + (tid & 31) * 4));
#pragma unroll
        for (int i = 0; i < 4; ++i) {
            float* d = sm + ((tid >> 5) + 16 * i) * 129 + (tid & 31) * 4;
            d[0] = v[i][0]; d[1] = v[i][1]; d[2] = v[i][2]; d[3] = v[i][3];
        }
        __syncthreads();
        {
            const int n = tid >> 2, kc = (tid & 3) * 16;
            u32x4 w0, w1;
            w0.x = cvt_pk_bf16(sm[(kc + 0) * 129 + n], sm[(kc + 1) * 129 + n]); w0.y = cvt_pk_bf16(sm[(kc + 2) * 129 + n], sm[(kc + 3) * 129 + n]);
            w0.z = cvt_pk_bf16(sm[(kc + 4) * 129 + n], sm[(kc + 5) * 129 + n]); w0.w = cvt_pk_bf16(sm[(kc + 6) * 129 + n], sm[(kc + 7) * 129 + n]);
            w1.x = cvt_pk_bf16(sm[(kc + 8) * 129 + n], sm[(kc + 9) * 129 + n]); w1.y = cvt_pk_bf16(sm[(kc + 10) * 129 + n], sm[(kc + 11) * 129 + n]);
            w1.z = cvt_pk_bf16(sm[(kc + 12) * 129 + n], sm[(kc + 13) * 129 + n]); w1.w = cvt_pk_bf16(sm[(kc + 14) * 129 + n], sm[(kc + 15) * 129 + n]);
            const int nn = n0 + n;
            bf16_t* dp = Wt + (size_t)((nn >> 7) * rs_hi + (nn & 127) + rs_off) * K + k0 + kc;
            *(u32x4*)dp = w0; *(u32x4*)(dp + 8) = w1;
        }
        __syncthreads();
    }
}

__device__ void rmsnorm_phase(const int wid_s, const float* __restrict__ x, const float* __restrict__ g, bf16_t* __restrict__ out) {
    const int tidx = tid_opaque();
    const int lane = tidx & 63, wv = blockIdx.x * 8 + (tidx >> 6), nw = gridDim.x * 8;
    for (int row = wv; row < T_; row += nw) {
        const float* xr = x + (size_t)row * 2048;
        f32x4 v[8]; float ss = 0.f;
#pragma unroll
        for (int i = 0; i < 8; ++i) { v[i] = *(const f32x4*)(xr + i * 256 + lane * 4); ss += v[i][0] * v[i][0] + v[i][1] * v[i][1] + v[i][2] * v[i][2] + v[i][3] * v[i][3]; }
        ss = wave_sum(ss);
        const float r = rsqrtf(ss * (1.f / 2048.f) + 1e-6f);
#pragma unroll
        for (int i = 0; i < 8; ++i) {
            const f32x4 gg = *(const f32x4*)(g + i * 256 + lane * 4);
            u32x2 w; w.x = cvt_pk_bf16(v[i][0] * r * gg[0], v[i][1] * r * gg[1]); w.y = cvt_pk_bf16(v[i][2] * r * gg[2], v[i][3] * r * gg[3]);
            *(u32x2*)(out + (size_t)row * 2048 + i * 256 + lane * 4) = w;
        }
    }
}

__device__ void conv_phase(const int wid_s, const int vb, const int nb, const bf16_t* __restrict__ proj, const float* __restrict__ w, const float* __restrict__ b, bf16_t* __restrict__ xc) {
    const int tidx = tid_opaque();
    const int gt = vb * NTHR + tidx, ng = nb * NTHR;
    for (int it = gt; it < T_ * 256; it += ng) {
        const int t = it >> 8, c = (it & 255) * 8, s = t & (S_ - 1);
        float y[8];
#pragma unroll
        for (int e = 0; e < 8; ++e) y[e] = b[c + e];
#pragma unroll
        for (int tap = 0; tap < 4; ++tap) {
            if (s - 3 + tap >= 0) {
                const u32x4 xw = *(const u32x4*)(proj + (size_t)(t - 3 + tap) * REC_IN + c);
                const float* wp = w + tap * 2048 + c;
                y[0] += bflo(xw.x) * wp[0]; y[1] += bfhi(xw.x) * wp[1]; y[2] += bflo(xw.y) * wp[2]; y[3] += bfhi(xw.y) * wp[3];
                y[4] += bflo(xw.z) * wp[4]; y[5] += bfhi(xw.z) * wp[5]; y[6] += bflo(xw.w) * wp[6]; y[7] += bfhi(xw.w) * wp[7];
            }
        }
        u32x4 o; o.x = cvt_pk_bf16(y[0], y[1]); o.y = cvt_pk_bf16(y[2], y[3]); o.z = cvt_pk_bf16(y[4], y[5]); o.w = cvt_pk_bf16(y[6], y[7]);
        *(u32x4*)(xc + (size_t)t * 2048 + c) = o;
    }
}

__device__ void scan_a_phase(const int wid_s, const int vb, const int nb, const bf16_t* __restrict__ la, const bf16_t* __restrict__ u, float* __restrict__ sumP, float* __restrict__ sumH) {
    const int tidx = tid_opaque();
    const int gt = vb * NTHR + tidx, ng = nb * NTHR;
    for (int it = gt; it < NB_ * 32 * 512; it += ng) {
        const int c4 = it & 511, ch = (it >> 9) & 31, b = it >> 14;
        const size_t base = ((size_t)(b * S_ + ch * 64)) * 2048 + c4 * 4;
        float sl[4] = {0.f, 0.f, 0.f, 0.f}, h[4] = {0.f, 0.f, 0.f, 0.f};
        for (int s0 = 0; s0 < 64; s0 += 16) {
            u32x2 aw[16], uw[16];
#pragma unroll
            for (int s = 0; s < 16; ++s) { aw[s] = *(const u32x2*)(la + base + (size_t)(s0 + s) * 2048); uw[s] = *(const u32x2*)(u + base + (size_t)(s0 + s) * 2048); }
            __builtin_amdgcn_sched_barrier(0);
#pragma unroll
            for (int s = 0; s < 16; ++s) {
                const float l[4] = {bflo(aw[s].x), bfhi(aw[s].x), bflo(aw[s].y), bfhi(aw[s].y)}, uu[4] = {bflo(uw[s].x), bfhi(uw[s].x), bflo(uw[s].y), bfhi(uw[s].y)};
#pragma unroll
                for (int e = 0; e < 4; ++e) { sl[e] += l[e]; h[e] = __expf(l[e]) * h[e] + uu[e]; }
            }
        }
        const size_t si = ((size_t)(b * 32 + ch)) * 2048 + c4 * 4;
        *(f32x4*)(sumP + si) = (f32x4){__expf(sl[0]), __expf(sl[1]), __expf(sl[2]), __expf(sl[3])}; *(f32x4*)(sumH + si) = (f32x4){h[0], h[1], h[2], h[3]};
    }
}
__device__ void scan_b_phase(const int wid_s, const int vb, const int nb, const bf16_t* __restrict__ la, const bf16_t* __restrict__ u, const float* __restrict__ sumP, const float* __restrict__ sumH,
                             const bf16_t* __restrict__ proj, bf16_t* __restrict__ y) {
    const int tidx = tid_opaque();
    const int gt = vb * NTHR + tidx, ng = nb * NTHR;
    for (int it = gt; it < NB_ * 32 * 512; it += ng) {
        const int c4 = it & 511, ch = (it >> 9) & 31, b = it >> 14;
        const size_t t0 = (size_t)(b * S_ + ch * 64);
        u32x2 aw[16], uw[16], gw[16];
#pragma unroll
        for (int s = 0; s < 16; ++s) { const size_t t = t0 + s; aw[s] = *(const u32x2*)(la + t * 2048 + c4 * 4); uw[s] = *(const u32x2*)(u + t * 2048 + c4 * 4); gw[s] = *(const u32x2*)(proj + t * REC_IN + 2048 + c4 * 4); }
        f32x4 h = (f32x4){0.f, 0.f, 0.f, 0.f};
        for (int j0 = 0; j0 < ch; j0 += 8) {
            f32x4 pv[8], hv[8];
#pragma unroll
            for (int j = 0; j < 8; ++j) { const int jj = (j0 + j < ch) ? j0 + j : ch - 1; const size_t si = ((size_t)(b * 32 + jj)) * 2048 + c4 * 4; pv[j] = *(const f32x4*)(sumP + si); hv[j] = *(const f32x4*)(sumH + si); }
            __builtin_amdgcn_sched_barrier(0);
#pragma unroll
            for (int j = 0; j < 8; ++j) if (j0 + j < ch) h = pv[j] * h + hv[j];
        }
        for (int s0 = 0; s0 < 64; s0 += 16) {
            __builtin_amdgcn_sched_barrier(0);
#pragma unroll
            for (int s = 0; s < 16; ++s) {
                const size_t t = t0 + s0 + s;
                h[0] = __expf(bflo(aw[s].x)) * h[0] + bflo(uw[s].x); h[1] = __expf(bfhi(aw[s].x)) * h[1] + bfhi(uw[s].x);
                h[2] = __expf(bflo(aw[s].y)) * h[2] + bflo(uw[s].y); h[3] = __expf(bfhi(aw[s].y)) * h[3] + bfhi(uw[s].y);
                *(u32x2*)(y + t * REC_OUT + c4 * 4) = (u32x2){cvt_pk_bf16(h[0] * bflo(gw[s].x), h[1] * bfhi(gw[s].x)), cvt_pk_bf16(h[2] * bflo(gw[s].y), h[3] * bfhi(gw[s].y))};
            }
            if (s0 + 16 < 64) {
#pragma unroll
                for (int s = 0; s < 16; ++s) { const size_t t = t0 + s0 + 16 + s; aw[s] = *(const u32x2*)(la + t * 2048 + c4 * 4); uw[s] = *(const u32x2*)(u + t * 2048 + c4 * 4); gw[s] = *(const u32x2*)(proj + t * REC_IN + 2048 + c4 * 4); }
            }
        }
    }
}
__device__ void att_qkv_phase(const int wid_s, bf16_t* __restrict__ proj, const float* __restrict__ qn, const float* __restrict__ kn, const float* __restrict__ ropetab, bf16_t* __restrict__ vT, bf16_t* sm) {
    const int tidx = tid_opaque();
    const int lane = tidx & 63, wv = blockIdx.x * 8 + (tidx >> 6), nw = gridDim.x * 8, j = lane & 15, gq = lane >> 4;
    float qw[8], kw8[8];
#pragma unroll
    for (int e = 0; e < 8; ++e) { qw[e] = qn[8 * j + e]; kw8[e] = kn[8 * j + e]; }
    for (int t = wv; t < T_; t += nw) {
        const int s = t & (S_ - 1);
        float cs[8], sn[8];
        {
            const float* rp = ropetab + s * 32 + (j & 1) * 8;
            const f32x4 c0 = *(const f32x4*)rp, c1 = *(const f32x4*)(rp + 4), s0 = *(const f32x4*)(rp + 16), s1 = *(const f32x4*)(rp + 20);
#pragma unroll
            for (int e = 0; e < 4; ++e) { cs[e] = c0[e]; cs[4 + e] = c1[e]; sn[e] = s0[e]; sn[4 + e] = s1[e]; }
        }
        bf16_t* row = proj + (size_t)t * ATT_IN + gq * 128 + 8 * j;
        u32x4 w[8];
#pragma unroll
        for (int c = 0; c < 8; ++c) w[c] = *(const u32x4*)(row + c * 512);
#pragma unroll
        for (int c = 0; c < 8; ++c) {
            float v[8] = {bflo(w[c].x), bfhi(w[c].x), bflo(w[c].y), bfhi(w[c].y), bflo(w[c].z), bfhi(w[c].z), bflo(w[c].w), bfhi(w[c].w)};
            float ss = 0.f;
#pragma unroll
            for (int e = 0; e < 8; ++e) ss += v[e] * v[e];
            ss += __shfl_xor(ss, 1); ss += __shfl_xor(ss, 2); ss += __shfl_xor(ss, 4); ss += __shfl_xor(ss, 8);
            const float r = rsqrtf(ss * (1.f / 128.f) + 1e-6f) * (c < 4 ? 0.12751743f : 1.f);
#pragma unroll
            for (int e = 0; e < 8; ++e) v[e] = v[e] * (c < 4 ? qw[e] : kw8[e]);
#pragma unroll
            for (int e = 0; e < 8; ++e) {
                const float o = __shfl_xor(v[e], 2);
                const float rot = j < 2 ? v[e] * cs[e] - o * sn[e] : v[e] * cs[e] + o * sn[e];
                v[e] = (j < 4 ? rot : v[e]) * r;
            }
            u32x4 o4; o4.x = cvt_pk_bf16(v[0], v[1]); o4.y = cvt_pk_bf16(v[2], v[3]); o4.z = cvt_pk_bf16(v[4], v[5]); o4.w = cvt_pk_bf16(v[6], v[7]);
            *(u32x4*)(row + c * 512) = o4;
        }
    }
    const int tid = tidx;
    for (int tile = blockIdx.x; tile < NB_ * 8 * 32 * 4; tile += gridDim.x) {
        const int vq = tile & 3, sb = (tile >> 2) & 31, hd = (tile >> 7) & 7, b = tile >> 10;
        {
            const int tok = tid >> 3, vc = (tid & 7) * 8;
            const u32x4 w = *(const u32x4*)(proj + ((size_t)(b * S_ + sb * 64 + tok)) * ATT_IN + 4096 + hd * 256 + vq * 64 + vc);
            *(u32x4*)(sm + tok * 72 + vc) = w;
        }
        __syncthreads();
        {
            const int vv = tid >> 3, tc = (tid & 7) * 8;
            unsigned short e[8];
#pragma unroll
            for (int i = 0; i < 8; ++i) e[i] = sm[(tc + i) * 72 + vv];
            u32x4 w; w.x = e[0] | ((unsigned)e[1] << 16); w.y = e[2] | ((unsigned)e[3] << 16); w.z = e[4] | ((unsigned)e[5] << 16); w.w = e[6] | ((unsigned)e[7] << 16);
            *(u32x4*)(vT + (((size_t)(b * 8 + hd)) * 256 + vq * 64 + vv) * S_ + sb * 64 + tc) = w;
        }
        __syncthreads();
    }
}

constexpr int HG_Q1 = 0, HG_Q2 = 17408, HG_K1 = 34816, HG_K2T = 52224, HG_VT = 70656, HG_P = 75264, HG_ST = 84480, HG_DEC = 93184, HG_TOT = 93696, HG_END = 97792;
static_assert(HG_END <= LDS_BYTES, "hgrn LDS");
__device__ __forceinline__ bf16x8 ldfrag(const LAS unsigned char* p) { return *(const LAS bf16x8*)p; }
__device__ __forceinline__ unsigned short bf1(float x) { return (unsigned short)(cvt_pk_bf16(x, 0.f) & 0xffffu); }


constexpr int HF_Q1 = 0, HF_Q2 = 17408, HF_K1 = 34816, HF_K2T = 52224, HF_VT = 70656, HF_P = 89088, HF_ST = 98304, HF_DEC = 133120, HF_TOT = 133632, HF_SSQ = 137728, HF_END = 138240;
static_assert(HF_END <= LDS_BYTES - 16, "hgrn full LDS");
template <int NVT>
__device__ void hgrn_full_phase(const int wid_s, const int item, const bf16_t* __restrict__ proj, const float* __restrict__ logfb, bf16_t* __restrict__ oraw,
                                const float* __restrict__ gon, bf16_t* __restrict__ y, LAS unsigned char* lds) {
    const int lane = lane_fresh(), tid = wid_s * 64 + lane, fr = lane & 15, fq = lane >> 4, w = wid_s;
    const int kp = lane, p8 = wid_s;
    const int b = NVT == 8 ? item >> 4 : item >> 5, hd = NVT == 8 ? item & 15 : (item >> 1) & 15, vs = NVT == 8 ? 0 : item & 1;
    constexpr int VW = 16 * NVT;
    for (int i = tid; i < (HF_DEC - HF_P) / 4; i += NTHR) ((LAS unsigned*)(lds + HF_P))[i] = 0u;
    f32x4 st[NVT];
#pragma unroll
    for (int n = 0; n < NVT; ++n) st[n] = (f32x4){0.f, 0.f, 0.f, 0.f};
    const float* lfp = logfb + ((size_t)(b * S_ + 8 * p8)) * 2048 + hd * 128 + 2 * kp;
    const bf16_t* qp = proj + ((size_t)(b * S_ + 8 * p8)) * REC_IN + 4096 + hd * 128 + 2 * kp;
    const bf16_t* vp = proj + ((size_t)(b * S_ + lane)) * REC_IN + 8192 + hd * 128 + vs * VW + w * (2 * NVT);
    f32x2 lfr[8]; unsigned qr[8], kr[8]; u32x4 vr0, vr1;
#pragma unroll
    for (int i = 0; i < 8; ++i) { lfr[i] = *(const f32x2*)(lfp + (size_t)i * 2048); qr[i] = *(const unsigned*)(qp + (size_t)i * REC_IN); kr[i] = *(const unsigned*)(qp + (size_t)i * REC_IN + 2048); }
    vr0 = *(const u32x4*)vp; vr1 = vr0; if (NVT == 8) vr1 = *(const u32x4*)(vp + 8);
    f32x4 ggh[NVT / 2];
#pragma unroll
    for (int q = 0; q < NVT / 2; ++q) ggh[q] = *(const f32x4*)(gon + 16 * ((w & 1) * (NVT / 2) + q) + 4 * fq);
    __syncthreads();
    for (int c = 0; c < 32; ++c) {
        f32x2 bl[8]; f32x2 cum = (f32x2){0.f, 0.f};
#pragma unroll
        for (int i = 0; i < 8; ++i) { cum += lfr[i]; bl[i] = cum; }
        *(LAS f32x2*)(lds + HF_TOT + (p8 * 128 + 2 * kp) * 4) = cum;
        __syncthreads();
        f32x2 off = (f32x2){0.f, 0.f}, bmid = (f32x2){0.f, 0.f}, blast = (f32x2){0.f, 0.f};
#pragma unroll
        for (int pp = 0; pp < 8; ++pp) {
            const f32x2 tv = *(const LAS f32x2*)(lds + HF_TOT + (pp * 128 + 2 * kp) * 4);
            if (pp < p8) off += tv;
            if (pp < 4) bmid += tv;
            blast += tv;
        }
        if (p8 == 0) *(LAS f32x2*)(lds + HF_DEC + 2 * kp * 4) = (f32x2){__builtin_amdgcn_exp2f(blast[0]), __builtin_amdgcn_exp2f(blast[1])};
        const f32x2 ek = (f32x2){__builtin_amdgcn_exp2f(blast[0] - bmid[0]), __builtin_amdgcn_exp2f(blast[1] - bmid[1])};
        float k2a[8], k2b[8];
#pragma unroll
        for (int i = 0; i < 8; ++i) {
            const int t = 8 * p8 + i;
            const f32x2 bq = off + bl[i];
            const float x0 = bq[0] - bmid[0], x1 = bq[1] - bmid[1];
            const float q0v = bflo(qr[i]), q1v = bfhi(qr[i]), k0v = bflo(kr[i]), k1v = bfhi(kr[i]);
            const float qa = q0v * __builtin_amdgcn_exp2f(fminf(x0, 115.f)), qb2 = q1v * __builtin_amdgcn_exp2f(fminf(x1, 115.f));
            const float ka = k0v * __builtin_amdgcn_exp2f(fminf(-x0, 115.f)), kb2 = k1v * __builtin_amdgcn_exp2f(fminf(-x1, 115.f));
            *(LAS unsigned*)(lds + HF_Q1 + t * 272 + kp * 4) = cvt_pk_bf16(qa, qb2);
            *(LAS unsigned*)(lds + HF_Q2 + t * 272 + kp * 4) = cvt_pk_bf16(q0v * __builtin_amdgcn_exp2f(bq[0]), q1v * __builtin_amdgcn_exp2f(bq[1]));
            *(LAS unsigned*)(lds + HF_K1 + t * 272 + kp * 4) = cvt_pk_bf16(ka, kb2);
            k2a[i] = ka * ek[0]; k2b[i] = kb2 * ek[1];
        }
        *(LAS u32x4*)(lds + HF_K2T + (2 * kp) * 144 + p8 * 16) = (u32x4){cvt_pk_bf16(k2a[0], k2a[1]), cvt_pk_bf16(k2a[2], k2a[3]), cvt_pk_bf16(k2a[4], k2a[5]), cvt_pk_bf16(k2a[6], k2a[7])};
        *(LAS u32x4*)(lds + HF_K2T + (2 * kp + 1) * 144 + p8 * 16) = (u32x4){cvt_pk_bf16(k2b[0], k2b[1]), cvt_pk_bf16(k2b[2], k2b[3]), cvt_pk_bf16(k2b[4], k2b[5]), cvt_pk_bf16(k2b[6], k2b[7])};
        {
            const int sv = lane, vv0 = w * (2 * NVT);
            const unsigned vw[8] = {vr0.x, vr0.y, vr0.z, vr0.w, vr1.x, vr1.y, vr1.z, vr1.w};
#pragma unroll
            for (int e = 0; e < NVT; ++e) {
                *(LAS unsigned short*)(lds + HF_VT + (vv0 + 2 * e) * 144 + sv * 2) = (unsigned short)(vw[e] & 0xffffu);
                *(LAS unsigned short*)(lds + HF_VT + (vv0 + 2 * e + 1) * 144 + sv * 2) = (unsigned short)(vw[e] >> 16);
            }
        }
        if (c + 1 < 32) {
            const size_t to = (size_t)(64 * (c + 1));
#pragma unroll
            for (int i = 0; i < 8; ++i) { lfr[i] = *(const f32x2*)(lfp + (to + i) * 2048); qr[i] = *(const unsigned*)(qp + (to + i) * REC_IN); kr[i] = *(const unsigned*)(qp + (to + i) * REC_IN + 2048); }
            vr0 = *(const u32x4*)(vp + to * REC_IN); if (NVT == 8) vr1 = *(const u32x4*)(vp + to * REC_IN + 8);
        }
        __syncthreads();
        for (int idx = w; idx < 10; idx += 8) {
            const int nt = idx >= 6 ? 3 : (idx >= 3 ? 2 : (idx >= 1 ? 1 : 0)), ms = idx - (nt * (nt + 1)) / 2;
            bf16x8 fa[4], fb[4];
#pragma unroll
            for (int ks = 0; ks < 4; ++ks) { fa[ks] = ldfrag(lds + HF_K1 + (16 * ms + fr) * 272 + 64 * ks + 16 * fq); fb[ks] = ldfrag(lds + HF_Q1 + (16 * nt + fr) * 272 + 64 * ks + 16 * fq); }
            __builtin_amdgcn_sched_barrier(0);
            f32x4 acc = (f32x4){0.f, 0.f, 0.f, 0.f}, acc2 = (f32x4){0.f, 0.f, 0.f, 0.f};
            acc = __builtin_amdgcn_mfma_f32_16x16x32_bf16(fa[0], fb[0], acc, 0, 0, 0);
            acc2 = __builtin_amdgcn_mfma_f32_16x16x32_bf16(fa[1], fb[1], acc2, 0, 0, 0);
            acc = __builtin_amdgcn_mfma_f32_16x16x32_bf16(fa[2], fb[2], acc, 0, 0, 0);
            acc2 = __builtin_amdgcn_mfma_f32_16x16x32_bf16(fa[3], fb[3], acc2, 0, 0, 0);
            acc += acc2;
            if (ms == nt) {
#pragma unroll
                for (int e = 0; e < 4; ++e) if (4 * fq + e > fr) acc[e] = 0.f;
            }
            *(LAS u32x2*)(lds + HF_P + (16 * nt + fr) * 144 + (16 * ms + 4 * fq) * 2) = (u32x2){cvt_pk_bf16_v(acc[0], acc[1]), cvt_pk_bf16_v(acc[2], acc[3])};
        }
        __syncthreads();
        f32x4 oacc[NVT / 2]; u32x2 gatew[NVT / 2];
        const int tt = w >> 1;
        {
            bf16x8 fb[6];
#pragma unroll
            for (int ks = 0; ks < 2; ++ks) fb[ks] = ldfrag(lds + HF_P + (16 * tt + fr) * 144 + 64 * ks + 16 * fq);
#pragma unroll
            for (int ks = 0; ks < 4; ++ks) fb[2 + ks] = ldfrag(lds + HF_Q2 + (16 * tt + fr) * 272 + 64 * ks + 16 * fq);
            if (NVT == 8) {
#pragma unroll
                for (int q = 0; q < NVT / 2; ++q)
                    gatew[q] = *(const u32x2*)(proj + ((size_t)(b * S_ + 64 * c + 16 * tt + fr)) * REC_IN + 10240 + hd * 128 + 16 * ((w & 1) * (NVT / 2) + q) + 4 * fq);
            }
#pragma unroll
            for (int q = 0; q < NVT / 2; ++q) {
                const int vt = (w & 1) * (NVT / 2) + q;
                bf16x8 fa[6];
#pragma unroll
                for (int ks = 0; ks < 2; ++ks) fa[ks] = ldfrag(lds + HF_VT + (16 * vt + fr) * 144 + 64 * ks + 16 * fq);
#pragma unroll
                for (int ks = 0; ks < 4; ++ks) fa[2 + ks] = ldfrag(lds + HF_ST + (16 * vt + fr) * 272 + 64 * ks + 16 * fq);
                __builtin_amdgcn_sched_barrier(0);
                f32x4 acc = (f32x4){0.f, 0.f, 0.f, 0.f}, acc2 = (f32x4){0.f, 0.f, 0.f, 0.f};
                acc = __builtin_amdgcn_mfma_f32_16x16x32_bf16(fa[0], fb[0], acc, 0, 0, 0);
                acc2 = __builtin_amdgcn_mfma_f32_16x16x32_bf16(fa[2], fb[2], acc2, 0, 0, 0);
                acc = __builtin_amdgcn_mfma_f32_16x16x32_bf16(fa[1], fb[1], acc, 0, 0, 0);
                acc2 = __builtin_amdgcn_mfma_f32_16x16x32_bf16(fa[3], fb[3], acc2, 0, 0, 0);
                acc = __builtin_amdgcn_mfma_f32_16x16x32_bf16(fa[4], fb[4], acc, 0, 0, 0);
                acc2 = __builtin_amdgcn_mfma_f32_16x16x32_bf16(fa[5], fb[5], acc2, 0, 0, 0);
                acc += acc2;
                if (NVT == 8) oacc[q] = acc;
                else *(u32x2*)(oraw + ((size_t)(b * S_ + 64 * c + 16 * tt + fr)) * 2048 + hd * 128 + vs * VW + 16 * vt + 4 * fq) = (u32x2){cvt_pk_bf16_v(acc[0], acc[1]), cvt_pk_bf16_v(acc[2], acc[3])};
            }
            if (NVT == 8) {
                float ps = 0.f;
#pragma unroll
                for (int q = 0; q < NVT / 2; ++q) ps += oacc[q][0] * oacc[q][0] + oacc[q][1] * oacc[q][1] + oacc[q][2] * oacc[q][2] + oacc[q][3] * oacc[q][3];
                ps += __shfl_xor(ps, 16); ps += __shfl_xor(ps, 32);
                if (fq == 0) ((LAS float*)(lds + HF_SSQ))[(w & 1) * 64 + 16 * tt + fr] = ps;
            }
            bf16x8 ka[2];
#pragma unroll
            for (int ks = 0; ks < 2; ++ks) ka[ks] = ldfrag(lds + HF_K2T + (16 * w + fr) * 144 + 64 * ks + 16 * fq);
            const f32x4 dv = *(const LAS f32x4*)(lds + HF_DEC + (16 * w + 4 * fq) * 4);
#pragma unroll
            for (int n = 0; n < NVT; n += 2) {
                bf16x8 vb2[4];
#pragma unroll
                for (int ks = 0; ks < 2; ++ks) { vb2[ks] = ldfrag(lds + HF_VT + (16 * n + fr) * 144 + 64 * ks + 16 * fq); vb2[2 + ks] = ldfrag(lds + HF_VT + (16 * n + 16 + fr) * 144 + 64 * ks + 16 * fq); }
                __builtin_amdgcn_sched_barrier(0);
                f32x4 s0 = st[n] * dv, s1 = st[n + 1] * dv;
                s0 = __builtin_amdgcn_mfma_f32_16x16x32_bf16(ka[0], vb2[0], s0, 0, 0, 0);
                s1 = __builtin_amdgcn_mfma_f32_16x16x32_bf16(ka[0], vb2[2], s1, 0, 0, 0);
                s0 = __builtin_amdgcn_mfma_f32_16x16x32_bf16(ka[1], vb2[1], s0, 0, 0, 0);
                s1 = __builtin_amdgcn_mfma_f32_16x16x32_bf16(ka[1], vb2[3], s1, 0, 0, 0);
                st[n] = s0; st[n + 1] = s1;
            }
        }
        __syncthreads();
        if (NVT == 8) {
            const float ssq = ((LAS float*)(lds + HF_SSQ))[16 * tt + fr] + ((LAS float*)(lds + HF_SSQ))[64 + 16 * tt + fr];
            const float rstd = rsqrtf(ssq * (1.f / 128.f) + 1e-6f);
#pragma unroll
            for (int q = 0; q < NVT / 2; ++q) {
                const int vv = 16 * ((w & 1) * (NVT / 2) + q) + 4 * fq;
                const f32x4 gg = ggh[q];
                const f32x4 o4 = oacc[q] * rstd * gg;
                *(u32x2*)(y + ((size_t)(b * S_ + 64 * c + 16 * tt + fr)) * REC_OUT + 2048 + hd * 128 + vv) =
                    (u32x2){cvt_pk_bf16_v(o4[0] * bflo(gatew[q].x), o4[1] * bfhi(gatew[q].x)), cvt_pk_bf16_v(o4[2] * bflo(gatew[q].y), o4[3] * bfhi(gatew[q].y))};
            }
        }
#pragma unroll
        for (int n = 0; n < NVT; ++n)
            *(LAS u32x2*)(lds + HF_ST + (16 * n + fr) * 272 + (16 * w + 4 * fq) * 2) = (u32x2){cvt_pk_bf16_v(st[n][0], st[n][1]), cvt_pk_bf16_v(st[n][2], st[n][3])};
    }
    __syncthreads();
}

__device__ __forceinline__ float xhalf_max(float x) { const auto r = __builtin_amdgcn_permlane32_swap(__float_as_uint(x), __float_as_uint(x), false, false); return fmaxf(__uint_as_float(r[0]), __uint_as_float(r[1])); }
__device__ __forceinline__ float xhalf_sum(float x) { const auto r = __builtin_amdgcn_permlane32_swap(__float_as_uint(x), __float_as_uint(x), false, false); return __uint_as_float(r[0]) + __uint_as_float(r[1]); }
typedef float f32x16 __attribute__((ext_vector_type(16)));
constexpr int AT_KROW = 272, AT_VROW = 72, AT_K2 = 32 * AT_KROW, AT_VT = 2 * AT_K2, AT_STAGE = AT_VT + 256 * AT_VROW;
constexpr int AT_Q = 2 * AT_STAGE;
static_assert(AT_Q + 8 * 32 * AT_KROW <= LDS_BYTES, "attention LDS");

__device__ void attn_phase(const int wid_s, const bf16_t* __restrict__ proj, const bf16_t* __restrict__ vT, const float* __restrict__ lamp, const float* __restrict__ gsub, const float mul,
                           bf16_t* __restrict__ y, LAS unsigned char* lds) {
    const int lane0 = lane_fresh(), rg = wid_s & 3, map = wid_s >> 2;
    const float lam = lamp[0];
    for (int pair = blockIdx.x; pair < 256; pair += gridDim.x) {
        const int pr = (gridDim.x == 256) ? ((pair & 7) * 32 + (pair >> 3)) : pair;
        const int qa = pr & 7, hd = (pr >> 3) & 7, b = pr >> 6;
        for (int half = 0; half < 2; ++half) {
            const int qb = half ? qa : 15 - qa;
            int lane = lane0; asm volatile("" : "+v"(lane));
            const int tid = wid_s * 64 + lane, r = lane & 31, h = lane >> 5;
            const int q0 = qb * 128 + rg * 32;
            const int nsteps = (qb + 1) * 4, mysteps = (q0 >> 5) + 1;
            const LAS unsigned char* qb_l = lds + AT_Q + wid_s * (32 * AT_KROW) + r * AT_KROW + 16 * h;
            {
                const int qr = lane >> 1, qc = (lane & 1) * 8;
                const bf16_t* qp = proj + ((size_t)(b * S_ + q0 + qr)) * ATT_IN + hd * 256 + map * 128 + qc * 8;
                LAS unsigned char* qw = lds + AT_Q + wid_s * (32 * AT_KROW) + qr * AT_KROW + qc * 16;
#pragma unroll
                for (int c = 0; c < 8; ++c) *(LAS u32x4*)(qw + c * 16) = *(const u32x4*)(qp + c * 8);
            }
            f32x16 o[8];
#pragma unroll
            for (int mt = 0; mt < 8; ++mt)
#pragma unroll
                for (int e = 0; e < 16; ++e) o[mt][e] = 0.f;
            float m = -INFINITY, l = 0.f;
            const bf16_t* kgb = proj + ((size_t)(b * S_)) * ATT_IN + 2048 + hd * 256;
            const bf16_t* vgb = vT + (((size_t)(b * 8 + hd)) * 256) * S_;
            const unsigned kgo = (unsigned)(tid >> 4) * ATT_IN + (tid & 15) * 8, vgo = (unsigned)(tid >> 2) * S_ + (tid & 3) * 8;
            const int kw = (tid >> 4) * AT_KROW + (tid & 15) * 16;
            const int vw = AT_VT + (tid >> 2) * AT_VROW + (tid & 3) * 16;
            u32x4 rk1, rk2, rv0, rv1;
            rk1 = *(const u32x4*)(kgb + kgo); rk2 = *(const u32x4*)(kgb + 128 + kgo); rv0 = *(const u32x4*)(vgb + vgo); rv1 = *(const u32x4*)(vgb + (size_t)128 * S_ + vgo);
            *(LAS u32x4*)(lds + kw) = rk1; *(LAS u32x4*)(lds + AT_K2 + kw) = rk2;
            *(LAS u32x2*)(lds + vw) = (u32x2){rv0.x, rv0.y}; *(LAS u32x2*)(lds + vw + 8) = (u32x2){rv0.z, rv0.w};
            *(LAS u32x2*)(lds + vw + 128 * AT_VROW) = (u32x2){rv1.x, rv1.y}; *(LAS u32x2*)(lds + vw + 128 * AT_VROW + 8) = (u32x2){rv1.z, rv1.w};
            __syncthreads();
            for (int i = 0; i < nsteps; ++i) {
                const int cur = (i & 1) * AT_STAGE, nxt = AT_STAGE - cur;
                const bool more = (i + 1 < nsteps);
                if (more) {
                    const bf16_t* kgi = kgb + (size_t)(32 * (i + 1)) * ATT_IN; const bf16_t* vgi = vgb + 32 * (i + 1);
                    rk1 = *(const u32x4*)(kgi + kgo); rk2 = *(const u32x4*)(kgi + 128 + kgo);
                    rv0 = *(const u32x4*)(vgi + vgo); rv1 = *(const u32x4*)(vgi + (size_t)128 * S_ + vgo);
                }
                if (i < mysteps) {
                    f32x16 st;
#pragma unroll
                    for (int e = 0; e < 16; ++e) st[e] = 0.f;
                    const LAS unsigned char* kb = lds + cur + map * AT_K2 + r * AT_KROW + 16 * h;
                    const LAS unsigned char* vb = lds + cur + AT_VT + r * AT_VROW + 8 * h;
                    {
                        bf16x8 kfa[4], qfa[4];
#pragma unroll
                        for (int e = 0; e < 4; ++e) { kfa[e] = *(const LAS bf16x8*)(kb + 32 * e); qfa[e] = *(const LAS bf16x8*)(qb_l + 32 * e); }
                        __builtin_amdgcn_sched_barrier(0);
                        f32x16 st2;
#pragma unroll
                        for (int e = 0; e < 16; ++e) st2[e] = 0.f;
                        st = __builtin_amdgcn_mfma_f32_32x32x16_bf16(kfa[0], qfa[0], st, 0, 0, 0);
                        st2 = __builtin_amdgcn_mfma_f32_32x32x16_bf16(kfa[1], qfa[1], st2, 0, 0, 0);
                        st = __builtin_amdgcn_mfma_f32_32x32x16_bf16(kfa[2], qfa[2], st, 0, 0, 0);
                        st2 = __builtin_amdgcn_mfma_f32_32x32x16_bf16(kfa[3], qfa[3], st2, 0, 0, 0);
#pragma unroll
                        for (int e = 0; e < 4; ++e) { kfa[e] = *(const LAS bf16x8*)(kb + 32 * (4 + e)); qfa[e] = *(const LAS bf16x8*)(qb_l + 32 * (4 + e)); }
                        __builtin_amdgcn_sched_barrier(0);
                        st = __builtin_amdgcn_mfma_f32_32x32x16_bf16(kfa[0], qfa[0], st, 0, 0, 0);
                        st2 = __builtin_amdgcn_mfma_f32_32x32x16_bf16(kfa[1], qfa[1], st2, 0, 0, 0);
                        st = __builtin_amdgcn_mfma_f32_32x32x16_bf16(kfa[2], qfa[2], st, 0, 0, 0);
                        st2 = __builtin_amdgcn_mfma_f32_32x32x16_bf16(kfa[3], qfa[3], st2, 0, 0, 0);
                        __builtin_amdgcn_sched_barrier(0);
#pragma unroll
                        for (int e = 0; e < 16; ++e) st[e] += st2[e];
                    }
                    u32x4 vfa[4];
#define AT_LDV(dst, mt, s2) do { const u32x2 _a0 = *(const LAS u32x2*)(vb + (mt) * 32 * AT_VROW + 32 * (s2)), _a1 = *(const LAS u32x2*)(vb + (mt) * 32 * AT_VROW + 32 * (s2) + 16); dst = (u32x4){_a0.x, _a0.y, _a1.x, _a1.y}; } while (0)
                    AT_LDV(vfa[0], 0, 0); AT_LDV(vfa[1], 1, 0); AT_LDV(vfa[2], 0, 1); AT_LDV(vfa[3], 1, 1);
                    __builtin_amdgcn_sched_barrier(0);
                    if (i == mysteps - 1) {
#pragma unroll
                        for (int e = 0; e < 16; ++e) { const int kk = (e & 3) + 8 * (e >> 2) + 4 * h; if (kk > r) st[e] = -INFINITY; }
                    }
                    float mloc = st[0];
#pragma unroll
                    for (int e = 1; e < 16; ++e) mloc = fmaxf(mloc, st[e]);
                    mloc = xhalf_max(mloc);
                    const float mnew = fmaxf(m, mloc);
                    if (__any(mloc - m > 8.f)) {
                        const float alpha = __builtin_amdgcn_exp2f(m - mnew);
                        l *= alpha;
#pragma unroll
                        for (int mt = 0; mt < 8; ++mt)
#pragma unroll
                            for (int e = 0; e < 16; ++e) o[mt][e] *= alpha;
                        m = mnew;
                    }
                    bf16x8 pf[2];
#pragma unroll
                    for (int s2 = 0; s2 < 2; ++s2) {
                        float pe[8];
#pragma unroll
                        for (int e = 0; e < 8; ++e) { pe[e] = __builtin_amdgcn_exp2f(st[8 * s2 + e] - m); l += pe[e]; }
                        u32x4 pw; pw.x = cvt_pk_bf16(pe[0], pe[1]); pw.y = cvt_pk_bf16(pe[2], pe[3]); pw.z = cvt_pk_bf16(pe[4], pe[5]); pw.w = cvt_pk_bf16(pe[6], pe[7]);
                        pf[s2] = __builtin_bit_cast(bf16x8, pw);
                    }
                    __builtin_amdgcn_sched_barrier(0);
#pragma unroll
                    for (int g = 0; g < 4; ++g) {
                        o[2 * g] = __builtin_amdgcn_mfma_f32_32x32x16_bf16(__builtin_bit_cast(bf16x8, vfa[0]), pf[0], o[2 * g], 0, 0, 0);
                        o[2 * g + 1] = __builtin_amdgcn_mfma_f32_32x32x16_bf16(__builtin_bit_cast(bf16x8, vfa[1]), pf[0], o[2 * g + 1], 0, 0, 0);
                        o[2 * g] = __builtin_amdgcn_mfma_f32_32x32x16_bf16(__builtin_bit_cast(bf16x8, vfa[2]), pf[1], o[2 * g], 0, 0, 0);
                        o[2 * g + 1] = __builtin_amdgcn_mfma_f32_32x32x16_bf16(__builtin_bit_cast(bf16x8, vfa[3]), pf[1], o[2 * g + 1], 0, 0, 0);
                        if (g < 3) { AT_LDV(vfa[0], 2 * g + 2, 0); AT_LDV(vfa[1], 2 * g + 3, 0); AT_LDV(vfa[2], 2 * g + 2, 1); AT_LDV(vfa[3], 2 * g + 3, 1); }
                        __builtin_amdgcn_sched_barrier(0);
                    }
#undef AT_LDV
                }
                if (more) {
                    *(LAS u32x4*)(lds + nxt + kw) = rk1; *(LAS u32x4*)(lds + nxt + AT_K2 + kw) = rk2;
                    *(LAS u32x2*)(lds + nxt + vw) = (u32x2){rv0.x, rv0.y}; *(LAS u32x2*)(lds + nxt + vw + 8) = (u32x2){rv0.z, rv0.w};
                    *(LAS u32x2*)(lds + nxt + vw + 128 * AT_VROW) = (u32x2){rv1.x, rv1.y}; *(LAS u32x2*)(lds + nxt + vw + 128 * AT_VROW + 8) = (u32x2){rv1.z, rv1.w};
                }
                __syncthreads();
            }
            l = xhalf_sum(l);
            int r2 = r, h2 = h; asm volatile("" : "+v"(r2), "+v"(h2));
            LAS float* ex = (LAS float*)lds + rg * 8192 + lane;
            if (map == 1) {
                const float sc = lam / l;
#pragma unroll
                for (int mt = 0; mt < 8; ++mt)
#pragma unroll
                    for (int e = 0; e < 16; ++e) ex[(mt * 16 + e) * 64] = o[mt][e] * sc;
            }
            __syncthreads();
            if (map == 0) {
                const float inv = 1.f / l;
                float ssq = 0.f;
#pragma unroll
                for (int mt = 0; mt < 8; ++mt)
#pragma unroll
                    for (int e = 0; e < 16; ++e) { const float v = o[mt][e] * inv - ex[(mt * 16 + e) * 64]; o[mt][e] = v; ssq += v * v; }
                ssq = xhalf_sum(ssq);
                const float rstd = rsqrtf(ssq * (1.f / 256.f) + 1e-5f) * mul;
                const size_t t = (size_t)(b * S_ + q0 + r2);
                const bf16_t* gp = proj + t * ATT_IN + 6144 + hd * 256 + 4 * h2;
                bf16_t* yp = y + t * 2048 + hd * 256 + 4 * h2;
                const float* gs = gsub + 4 * h2;
#pragma unroll
                for (int mt = 0; mt < 8; ++mt)
#pragma unroll
                    for (int g4 = 0; g4 < 4; ++g4) {
                        const int v0 = 32 * mt + 8 * g4;
                        const u32x2 gw = *(const u32x2*)(gp + v0);
                        const f32x4 gg = *(const f32x4*)(gs + v0);
                        u32x2 ow;
                        ow.x = cvt_pk_bf16(o[mt][4 * g4 + 0] * rstd * gg[0] * bflo(gw.x), o[mt][4 * g4 + 1] * rstd * gg[1] * bfhi(gw.x));
                        ow.y = cvt_pk_bf16(o[mt][4 * g4 + 2] * rstd * gg[2] * bflo(gw.y), o[mt][4 * g4 + 3] * rstd * gg[3] * bfhi(gw.y));
                        *(u32x2*)(yp + v0) = ow;
                    }
            }
            __syncthreads();
        }
    }
}


#define XB_TMO      128
#define XB_XCNT(j)  (256  + 64 * (j))
#define XB_XSUB(j)  (1280 + 64 * (j))
#define XB_XGEN(j)  (2304 + 64 * (j))
#define XB_TOP      3328
#define XB_TOPGEN   3392
#define XCD_BAR_WORDS 3456
#define XB_SPIN_CAP (1u << 18)
__device__ __forceinline__ unsigned xb_ld(unsigned* p)              { return __hip_atomic_load(p, __ATOMIC_RELAXED, __HIP_MEMORY_SCOPE_AGENT); }
__device__ __forceinline__ unsigned xb_add(unsigned* p, unsigned v) { return __hip_atomic_fetch_add(p, v, __ATOMIC_RELAXED, __HIP_MEMORY_SCOPE_AGENT); }
__device__ __forceinline__ unsigned xb_xcc_id() { return (unsigned)__builtin_amdgcn_s_getreg((3 << 11) | 20) & 0xFu; }
#define XB_SPIN(cond, bar) do { unsigned _sp = 0; while (cond) { __builtin_amdgcn_s_sleep(1); \
    if ((++_sp & 255u) == 0u) { if (xb_ld(&(bar)[XB_TMO])) break; if (_sp > XB_SPIN_CAP) { atomicAdd(&(bar)[XB_TMO], 1u); break; } } } } while (0)
struct XcdBarrier { unsigned* bar; unsigned x; volatile LAS unsigned* st; unsigned total; };
__device__ __forceinline__ XcdBarrier xcd_barrier_post(unsigned* bar, volatile LAS unsigned* st, unsigned total) {
    XcdBarrier b; b.bar = bar; b.x = xb_xcc_id(); b.st = st; b.total = total;
    if (threadIdx.x == 0) (void)xb_add(&bar[XB_XCNT(b.x)], 1u);
    return b;
}
__device__ __forceinline__ void xcd_barrier_complete(unsigned* bar, unsigned x, unsigned G, unsigned& nloc, unsigned& nx) {
    unsigned sum, cnt, mine, sp = 0u;
    for (;;) {
        sum = 0u; cnt = 0u; mine = 0u;
#pragma unroll
        for (unsigned j = 0; j < 16; ++j) { const unsigned c = xb_ld(&bar[XB_XCNT(j)]); sum += c; cnt += (c > 0u) ? 1u : 0u; mine = (j == x) ? c : mine; }
        if (sum == G) break;
        __builtin_amdgcn_s_sleep(1);
        if ((++sp & 255u) == 0u) { if (xb_ld(&bar[XB_TMO])) break; if (sp > XB_SPIN_CAP) { atomicAdd(&bar[XB_TMO], 1u); break; } }
    }
    nloc = mine > 0u ? mine : 1u; nx = cnt > 0u ? cnt : 1u;
}
__device__ __forceinline__ void xcd_barrier(const XcdBarrier& b) {
    asm volatile("s_waitcnt vmcnt(0)" ::: "memory");
    __syncthreads();
    if (threadIdx.x == 0) {
        unsigned* bar = b.bar;
        __builtin_amdgcn_s_waitcnt(0);
        unsigned nloc = b.st[0], nx = b.st[1];
        if (nloc == 0u) { xcd_barrier_complete(bar, b.x, b.total, nloc, nx); b.st[0] = nloc; b.st[1] = nx; }
        const unsigned old = xb_add(&bar[XB_XSUB(b.x)], 1u);
        const unsigned gen = old / nloc;
        if (old + 1u == (gen + 1u) * nloc) {
            __builtin_amdgcn_fence(__ATOMIC_RELEASE, "agent");
            asm volatile("s_waitcnt vmcnt(0)" ::: "memory");
            const unsigned og = xb_add(&bar[XB_TOP], 1u);
            const unsigned tg = og / nx;
            if (og + 1u == (tg + 1u) * nx) xb_add(&bar[XB_TOPGEN], 1u);
            else XB_SPIN(xb_ld(&bar[XB_TOPGEN]) == tg, bar);
            __builtin_amdgcn_fence(__ATOMIC_ACQUIRE, "agent");
            xb_add(&bar[XB_XGEN(b.x)], 1u);
            asm volatile("s_waitcnt vmcnt(0)" ::: "memory");
        } else {
            XB_SPIN(xb_ld(&bar[XB_XGEN(b.x)]) == gen, bar);
            __builtin_amdgcn_fence(__ATOMIC_ACQUIRE, "agent");
            asm volatile("s_waitcnt vmcnt(0)" ::: "memory");
        }
    }
    __syncthreads();
}
constexpr size_t WS_BAR = WS_SMALL + 32768;
constexpr int LDS_BARST = LDS_BYTES - 16;
constexpr size_t WS_BAR2 = WS_BAR + 16384;
static_assert(true, "");
constexpr int NA_BLOCKS = 64;
static_assert(AT_Q + 8 * 32 * AT_KROW <= LDS_BARST && XCD_BAR_WORDS * 4 + 32768 + 16384 <= 65536, "barrier words");

__device__ __forceinline__ int opaque0() { int z = 0; asm volatile("" : "+s"(z)); return z; }
#define PIN(k) (p.in[(k) + opaque0()])
#define WSP(type, off) ((type*)(ws + (off) + (size_t)opaque0()))

__global__ void __launch_bounds__(NTHR, 2) mega(Params p) {
    extern __shared__ __attribute__((aligned(16))) unsigned char lds_raw[];
    LAS unsigned char* lds = (LAS unsigned char*)lds_raw;
    cg::grid_group grid = cg::this_grid();
    unsigned char* ws = p.ws;
    const int G = gridDim.x;
    const int wid_s = __builtin_amdgcn_readfirstlane(threadIdx.x >> 6);
    int ph = 0;
    const int lo = p.ph_lo, hi = p.ph_hi;
    volatile LAS unsigned* bst = (volatile LAS unsigned*)(lds + LDS_BARST);
    if (threadIdx.x < 4) bst[threadIdx.x] = 0u;
    __syncthreads();
    XcdBarrier xbar = xcd_barrier_post((unsigned*)(ws + WS_BAR), bst, G);
    XcdBarrier xbarB; xbarB.bar = (unsigned*)(ws + WS_BAR2); xbarB.x = xbar.x; xbarB.st = bst + 2; xbarB.total = G - NA_BLOCKS;
    if ((int)blockIdx.x >= NA_BLOCKS) xbarB = xcd_barrier_post((unsigned*)(ws + WS_BAR2), bst + 2, G - NA_BLOCKS);
#ifndef PROBE_DUP
#define PROBE_DUP 0
#endif
#define PHASE_BEGIN_K(kind) if (ph >= lo && ph < hi) { for (int rep = 0; rep <= ((PROBE_DUP >> (kind)) & 1); ++rep) { if (rep) __syncthreads();
#define PHASE_BEGIN PHASE_BEGIN_K(31)
#define PHASE_END   } if (ph + 1 < hi) { if (hi < 0) grid.sync(); else xcd_barrier(xbar); } } ++ph;

    PHASE_BEGIN_K(0)
        const int tid = tid_opaque();
        transpose_w(wid_s, blockIdx.x, G, PIN(2), WSP(bf16_t, WS_W_REC_IN), 2048, REC_IN, (float*)lds_raw);
        {
            const int mt = blockIdx.x >> 3, vbt = blockIdx.x & 7;
            for (int m = mt; m < 32; m += (G + 7) / 8) {
                const int isx = m & 1, hd = (m >> 1) & 7, j = m >> 4;
                const float* src = (isx ? PIN(7) : PIN(5)) + (size_t)(j * 8 + hd) * 65536;
                transpose_w(wid_s, vbt, 8, src, WSP(bf16_t, WS_W_GATE) + (size_t)(j * 16 + hd * 2) * 65536, 256, 256, (float*)lds_raw, 256, 128 * isx);
            }
        }
        float* lb_all = WSP(float, WS_SMALL); float* lamv = lb_all + 4096;
        if (blockIdx.x == 0) {
            const float* hl = PIN(10);
            for (int c = tid; c < 2048; c += NTHR) {
                const float l0 = hl[c], l1 = hl[2048 + c];
                const float m = fmaxf(l0, l1), e0 = __expf(l0 - m), e1 = __expf(l1 - m);
                const float p0 = e0 / (e0 + e1), p1 = e1 / (e0 + e1);
                lb_all[c] = 0.f; lb_all[2048 + c] = (p0 + p1) - p0;
            }
        }
        if (blockIdx.x == 1 && tid < 128) {
            const int j = tid >> 6, lane = tid & 63;
            const float* lp = PIN(17) + j * 512;
            float a1 = lp[lane] * lp[128 + lane] + lp[lane + 64] * lp[128 + lane + 64];
            float a2 = lp[256 + lane] * lp[384 + lane] + lp[256 + lane + 64] * lp[384 + lane + 64];
            a1 = wave_sum(a1); a2 = wave_sum(a2);
            if (lane == 0) lamv[j] = expf(a1) - expf(a2) + p.lam_init[j];
        }
        {
            float* rt = WSP(float, WS_ROPE);
            for (int i = blockIdx.x * NTHR + tid; i < S_ * 16; i += G * NTHR) {
                const int pos = i >> 4, fi = i & 15;
                const float angf = (float)pos * p.inv_freq[fi];
                const double ang = (double)angf;
                const double kk = rint(ang * 0.15915494309189535);
                const float rr = (float)(ang - kk * 6.283185307179586);
                rt[pos * 32 + fi] = cosf(rr); rt[pos * 32 + 16 + fi] = sinf(rr);
            }
        }
        { float* ssz = WSP(float, WS_SS); for (int i = blockIdx.x * NTHR + tid; i < 3 * T_; i += G * NTHR) ssz[i] = 0.f; }
        rmsnorm_phase(wid_s, PIN(0), PIN(1), WSP(bf16_t, WS_H));
    PHASE_END

    for (int layer = 0; layer < 4; ++layer) {
        const int j = layer >> 1;
        if ((layer & 1) == 0) {
            PHASE_BEGIN_K(1)
                pg8::Gemm g{WSP(bf16_t, WS_H), WSP(bf16_t, WS_W_REC_IN) + (size_t)j * REC_IN * 2048, 2048, 2048}; pg8::StaticOrder S; S.init(T_, REC_IN, G, blockIdx.x);
                pg8::EpiRecIn E{WSP(bf16_t, WS_PROJ), WSP(float, WS_S0), WSP(float, WS_SMALL) + j * 2048, layer == 0 ? (const float*)nullptr : WSP(float, WS_SS) + (size_t)(layer - 1) * T_};
                pg8::gemm_phase(wid_s, lds, g, S, E);
            PHASE_END
            PHASE_BEGIN_K(2)
                if ((int)blockIdx.x < NA_BLOCKS) {
                    hgrn_full_phase<NA_BLOCKS == 64 ? 8 : 4>(wid_s, blockIdx.x, WSP(bf16_t, WS_PROJ), WSP(float, WS_S0), WSP(bf16_t, WS_ORAW), PIN(11) + j * 128, WSP(bf16_t, WS_Y), lds);
                } else {
                    const int vb = blockIdx.x - NA_BLOCKS, nb = G - NA_BLOCKS;
                    bf16_t* hb = WSP(bf16_t, WS_H); bf16_t* proj = WSP(bf16_t, WS_PROJ);
                    bf16_t* lab = WSP(bf16_t, WS_S1); bf16_t* ub = lab + (size_t)T_ * 2048;
                    float* sumP = WSP(float, WS_SUM);
                    conv_phase(wid_s, vb, nb, proj, PIN(3) + j * 4 * 2048, PIN(4) + j * 2048, hb);
                    xcd_barrier(xbarB);
                    {
                        pg8::Gemm g{hb, WSP(bf16_t, WS_W_GATE) + (size_t)j * 16 * 256 * 256, 2048, 256 + opaque0()}; pg8::GateOrder S{nb, vb};
                        pg8::EpiGate E{hb, PIN(6) + j * 2048, PIN(8) + j * 2048, PIN(9) + j * 2048, lab, ub};
                        pg8::gemm_phase(wid_s, lds, g, S, E);
                    }
                    xcd_barrier(xbarB);
                    scan_a_phase(wid_s, vb, nb, lab, ub, sumP, sumP + NB_ * 32 * 2048);
                    xcd_barrier(xbarB);
                    scan_b_phase(wid_s, vb, nb, lab, ub, sumP, sumP + NB_ * 32 * 2048, proj, WSP(bf16_t, WS_Y));
                    __syncthreads();
                    transpose_w(wid_s, vb, nb, PIN(14) + (size_t)j * 2048 * ATT_IN, WSP(bf16_t, WS_W_ATT_IN) + (size_t)j * ATT_IN * 2048, 2048, ATT_IN, (float*)lds_raw);
                    transpose_w(wid_s, vb, nb, PIN(19) + (size_t)j * 2048 * 2048, WSP(bf16_t, WS_W_ATT_OUT) + (size_t)j * 2048 * 2048, 2048, 2048, (float*)lds_raw);
                    if (j == 0) {
                        transpose_w(wid_s, vb, nb, PIN(12), WSP(bf16_t, WS_W_REC_OUT), REC_OUT, 2048, (float*)lds_raw);
                        transpose_w(wid_s, vb, nb, PIN(2) + (size_t)2048 * REC_IN, WSP(bf16_t, WS_W_REC_IN) + (size_t)REC_IN * 2048, 2048, REC_IN, (float*)lds_raw);
                        transpose_w(wid_s, vb, nb, PIN(12) + (size_t)REC_OUT * 2048, WSP(bf16_t, WS_W_REC_OUT) + (size_t)2048 * REC_OUT, REC_OUT, 2048, (float*)lds_raw);
                    }
                }
            PHASE_END
        } else {
            PHASE_BEGIN_K(7)
                pg8::Gemm g{WSP(bf16_t, WS_H), WSP(bf16_t, WS_W_ATT_IN) + (size_t)j * ATT_IN * 2048, 2048, 2048}; pg8::StaticOrder S; S.init(T_, ATT_IN, G, blockIdx.x);
                pg8::EpiAttIn E{WSP(bf16_t, WS_PROJ), WSP(float, WS_SS) + (size_t)(layer - 1) * T_, PIN(15) + j * 128, PIN(16) + j * 128, WSP(float, WS_ROPE), WSP(bf16_t, WS_S0), lds + 131072};
                pg8::gemm_phase(wid_s, lds, g, S, E);
            PHASE_END
            PHASE_BEGIN_K(9)
                                attn_phase(wid_s, WSP(bf16_t, WS_PROJ), WSP(const bf16_t, WS_S0), WSP(float, WS_SMALL) + 4096 + j, PIN(18) + j * 256, 1.f - p.lam_init[j], WSP(bf16_t, WS_Y), lds);
            PHASE_END
        }
        PHASE_BEGIN_K(10)
            const bool rec = (layer & 1) == 0;
            const int Ko = rec ? REC_OUT : 2048;
            float* xbuf = WSP(float, WS_X);
            const float* xres = layer == 0 ? PIN(0) : xbuf;
            float* xdst = layer == 3 ? p.out : xbuf;
            pg8::Gemm g{WSP(bf16_t, WS_Y), rec ? WSP(bf16_t, WS_W_REC_OUT) + (size_t)j * 2048 * REC_OUT : WSP(bf16_t, WS_W_ATT_OUT) + (size_t)j * 2048 * 2048, Ko, Ko}; pg8::StaticOrder S; S.init(T_, 2048, G, blockIdx.x);
            const int nl = layer + 1;
            const float* gn = layer == 3 ? (const float*)nullptr : ((nl & 1) ? PIN(13) + (nl >> 1) * 2048 : PIN(1) + (nl >> 1) * 2048);
            pg8::EpiResid E{xres, xdst, gn, WSP(bf16_t, WS_H), WSP(float, WS_SS) + (size_t)layer * T_};
            pg8::gemm_phase(wid_s, lds, g, S, E);
        PHASE_END
    }
}

constexpr int N_PHASES = 1 + 3 + 3 + 3 + 3;

extern "C" void kernel_launch(void* const* d_in, const int* in_sizes, int n_in, void* d_out, int out_size, void* d_ws, size_t ws_size, hipStream_t stream) {
    static int grid = 0;
    if (grid == 0) {
        if (n_in != 20 || ws_size < WS_END) { fprintf(stderr, "kernel_launch: bad inputs (n_in %d, ws %zu < %zu)\n", n_in, ws_size, (size_t)WS_END); grid = -1; return; }
        int dev = 0, cus = 0, per_cu = 0;
        if (hipGetDevice(&dev) != hipSuccess || hipDeviceGetAttribute(&cus, hipDeviceAttributeMultiprocessorCount, dev) != hipSuccess) { grid = -1; return; }
        if (hipFuncSetAttribute((const void*)mega, hipFuncAttributeMaxDynamicSharedMemorySize, LDS_BYTES) != hipSuccess) { fprintf(stderr, "hipFuncSetAttribute failed\n"); grid = -1; return; }
        if (hipOccupancyMaxActiveBlocksPerMultiprocessor(&per_cu, (const void*)mega, NTHR, LDS_BYTES) != hipSuccess || per_cu < 1) { fprintf(stderr, "occupancy query failed (%d)\n", per_cu); grid = -1; return; }
        grid = cus * per_cu;
        if (grid > 256) grid = 256;
        if (grid != 256) { fprintf(stderr, "kernel_launch: this kernel needs exactly 256 resident workgroups (got %d)\n", grid); grid = -1; return; }
    }
    if (grid < 0) return;
    Params p;
    memset(&p, 0, sizeof(p));
    for (int i = 0; i < 20; ++i) p.in[i] = (const float*)d_in[i];
    p.out = (float*)d_out; p.ws = (unsigned char*)d_ws;
    for (int i = 0; i < 16; ++i) p.inv_freq[i] = (float)pow(500000.0, -(double)(2 * i) / 32.0);
    p.lam_init[0] = (float)(0.8 - 0.6 * exp(-0.3 * 1.0));
    p.lam_init[1] = (float)(0.8 - 0.6 * exp(-0.3 * 3.0));
    p.ph_lo = 0; p.ph_hi = N_PHASES;
    if (hipMemsetAsync((unsigned char*)d_ws + WS_BAR, 0, 16384 + XCD_BAR_WORDS * 4, stream) != hipSuccess) { fprintf(stderr, "memset of barrier words failed\n"); return; }
    void* args[] = {&p};
    hipError_t e = hipLaunchCooperativeKernel((const void*)mega, dim3(grid), dim3(NTHR), args, LDS_BYTES, stream);
    if (e != hipSuccess) fprintf(stderr, "cooperative launch failed: %s (grid %d)\n", hipGetErrorString(e), grid);
}
```
